# Optimizing an MI355X kernel written in HIP

```python
import math
import jax, jax.numpy as jnp
from jax import lax
import numpy as np

D_MODEL = 1024
BATCH = 8
SEQ = 4096
DEPTH = 1

N_META = 16
BLOCK = 128
PREFIX = BLOCK
N_PAD = PREFIX - N_META

GLA_HEADS = 4
GLA_DK = 64
GLA_DV = 128
GLA_GATE_RANK = 16
GLA_TAU = 16.0
GLA_CHUNK = 64
GLA_QK = GLA_HEADS * GLA_DK
GLA_V = GLA_HEADS * GLA_DV

FOX_HEADS = 8
FOX_DH = 64
FOX_W = FOX_HEADS * FOX_DH

MIX_W = GLA_V + FOX_W
IN_SPLITS = (GLA_QK, GLA_QK, GLA_V, GLA_V, GLA_GATE_RANK, FOX_W, FOX_W, FOX_W, FOX_HEADS)
IN_W = 2 * GLA_QK + 2 * GLA_V + GLA_GATE_RANK + 3 * FOX_W + FOX_HEADS

PEER_HEADS = 8
PEER_NKEYS = 128
PEER_EXPERTS = PEER_NKEYS * PEER_NKEYS
PEER_DKEY = 256
PEER_TOPK = 16
PEER_TOK_BLOCK = 128

DN_ALPHA = (2.0 * DEPTH) ** 0.25
DN_BETA = (8.0 * DEPTH) ** -0.25
LN_EPS = 1e-5
NEG = -1e30

kernel_name = "hymba_gla_fox_peer_deepnorm"


def layer_norm(x, g, b):
    xf = x.astype(jnp.float32)
    mu = jnp.mean(xf, -1, keepdims=True)
    var = jnp.mean(jnp.square(xf - mu), -1, keepdims=True)
    return ((xf - mu) * lax.rsqrt(var + LN_EPS) * g.astype(jnp.float32) + b.astype(jnp.float32)).astype(x.dtype)


def head_rmsnorm(o, g):
    r = o * lax.rsqrt(jnp.mean(jnp.square(o), -1, keepdims=True) + LN_EPS)
    return r * g.astype(jnp.float32).reshape(o.shape[-2:])


def gla_mix(q, k, v, glog, valid):
    B, L, H, dk = q.shape
    dv = v.shape[-1]
    C = GLA_CHUNK
    N = L // C
    scale = dk ** -0.5
    k = k * valid[None, :, None, None].astype(k.dtype)

    def chunked(t):
        return t.reshape(B, N, C, H, t.shape[-1]).transpose(0, 3, 1, 2, 4)

    q, k, v, glog = chunked(q), chunked(k), chunked(v), chunked(glog)
    bcum = jnp.cumsum(glog, axis=3)
    b_ref = bcum[:, :, :, C // 2 - 1:C // 2, :]
    q_in = q * jnp.exp(bcum - b_ref)
    k_in = k * jnp.exp(b_ref - bcum)
    causal = jnp.tril(jnp.ones((C, C), dtype=bool))
    a = jnp.einsum('bhncd,bhnsd->bhncs', q_in, k_in) * scale
    a = jnp.where(causal, a, 0.0)
    o_intra = jnp.einsum('bhncs,bhnsv->bhncv', a, v)

    b_last = bcum[:, :, :, -1:, :]
    d_state = jnp.einsum('bhncd,bhncv->bhndv', k * jnp.exp(b_last - bcum), v)
    decay = jnp.exp(b_last[:, :, :, 0, :])[..., None]

    def step(S, inp):
        dec, ds = inp
        return dec * S + ds, S

    S0 = jnp.zeros((B, H, dk, dv), jnp.float32)
    _, S_prev = lax.scan(step, S0, (jnp.moveaxis(decay, 2, 0), jnp.moveaxis(d_state, 2, 0)))
    S_prev = jnp.moveaxis(S_prev, 0, 2)
    o_inter = jnp.einsum('bhncd,bhndv->bhncv', q * jnp.exp(bcum), S_prev) * scale
    o = o_intra + o_inter
    return o.transpose(0, 2, 3, 1, 4).reshape(B, L, H, dv)


def fox_mix(q, k, v, logf, valid):
    B, L, H, d = q.shape
    scale = d ** -0.5
    q, k, v = (t.transpose(0, 2, 1, 3) for t in (q, k, v))
    c = jnp.cumsum(logf, axis=1).transpose(0, 2, 1)
    pos = jnp.arange(L)
    outs = []
    for i in range(L // BLOCK):
        s0, e = i * BLOCK, (i + 1) * BLOCK
        logits = jnp.einsum('bhqd,bhkd->bhqk', q[:, :, s0:e], k[:, :, :e]) * scale
        logits = logits + c[:, :, s0:e, None] - c[:, :, None, :e]
        mask = (pos[None, :e] <= pos[s0:e, None]) & valid[None, :e]
        p = jax.nn.softmax(jnp.where(mask, logits, NEG), axis=-1)
        outs.append(jnp.einsum('bhqk,bhkd->bhqd', p, v[:, :, :e]))
    o = jnp.concatenate(outs, axis=2)
    return o.transpose(0, 2, 1, 3)


def hybrid_mixer(h, w_in, w_gate_up, b_gate, b_forget, gla_norm_g, fox_norm_g, w_out, valid):
    B, L, _ = h.shape
    proj = (h @ w_in).astype(jnp.float32)
    bounds, acc = [], 0
    for w in IN_SPLITS[:-1]:
        acc += w
        bounds.append(acc)
    qa, ka, va, ra, ga, qb, kb, vb, fb = jnp.split(proj, bounds, axis=-1)

    glog = jax.nn.log_sigmoid(ga @ w_gate_up.astype(jnp.float32) + b_gate.astype(jnp.float32)) / GLA_TAU
    hA = lambda t, d: t.reshape(B, L, GLA_HEADS, d)
    oa = gla_mix(hA(qa, GLA_DK), hA(ka, GLA_DK), hA(va, GLA_DV), hA(glog, GLA_DK), valid)
    oa = head_rmsnorm(oa, gla_norm_g).reshape(B, L, GLA_V) * jax.nn.silu(ra)

    logf = jax.nn.log_sigmoid(fb + b_forget.astype(jnp.float32))
    hB = lambda t: t.reshape(B, L, FOX_HEADS, FOX_DH)
    ob = fox_mix(hB(qb), hB(kb), hB(vb), logf, valid)
    ob = head_rmsnorm(ob, fox_norm_g).reshape(B, L, FOX_W)

    o = jnp.concatenate([oa, ob], axis=-1).astype(h.dtype)
    return o @ w_out


def peer(h, w_q, sub_keys, u_tab, v_tab):
    B, L, D = h.shape
    T = B * L
    xt = h.reshape(T, D)
    q = (xt @ w_q).astype(jnp.float32).reshape(T, PEER_HEADS, 2, PEER_DKEY // 2)
    s = jnp.einsum('thcd,hcnd->thcn', q, sub_keys.astype(jnp.float32))
    top_s, top_i = lax.top_k(s, PEER_TOPK)
    cand_s = (top_s[:, :, 0, :, None] + top_s[:, :, 1, None, :]).reshape(T, PEER_HEADS, -1)
    cand_e = (top_i[:, :, 0, :, None] * PEER_NKEYS + top_i[:, :, 1, None, :]).reshape(T, PEER_HEADS, -1)
    best_s, best_j = lax.top_k(cand_s, PEER_TOPK)
    experts = jnp.take_along_axis(cand_e, best_j, axis=-1)
    gates = jax.nn.softmax(best_s, axis=-1)

    nb, tb, hk = T // PEER_TOK_BLOCK, PEER_TOK_BLOCK, PEER_HEADS * PEER_TOPK

    def block(args):
        xb, eb, gb = args
        act = jax.nn.gelu(jnp.einsum('td,tkd->tk', xb, u_tab[eb]), approximate=False)
        return jnp.einsum('tk,tkd->td', gb.astype(xb.dtype) * act, v_tab[eb])

    y = lax.map(block, (xt.reshape(nb, tb, D), experts.reshape(nb, tb, hk), gates.reshape(nb, tb, hk)))
    return y.reshape(B, L, D)


def setup_inputs(seed: int = 0) -> dict:
    key = jax.random.key(seed)
    ks = jax.random.split(key, 20)
    nrm = lambda k, shape: jax.random.normal(k, shape, jnp.float32)
    D = D_MODEL
    col_scale = jnp.concatenate([
        jnp.ones((2 * GLA_QK,)), jnp.full((GLA_V,), DN_BETA), jnp.ones((GLA_V + GLA_GATE_RANK + 2 * FOX_W,)),
        jnp.full((FOX_W,), DN_BETA), jnp.ones((FOX_HEADS,))]).astype(jnp.float32)
    return {
        "x": nrm(ks[0], (BATCH, SEQ, D)),
        "meta_tokens": nrm(ks[1], (N_META, D)),
        "emb_ln_g": 1.0 + 0.02 * nrm(ks[2], (D,)),
        "emb_ln_b": 0.02 * nrm(ks[3], (D,)),
        "w_in": nrm(ks[4], (DEPTH, D, IN_W)) * (D ** -0.5) * col_scale,
        "w_gate_up": nrm(ks[5], (DEPTH, GLA_GATE_RANK, GLA_QK)) * (GLA_GATE_RANK ** -0.5),
        "b_gate": 0.02 * nrm(ks[6], (DEPTH, GLA_QK)),
        "b_forget": jax.random.uniform(ks[7], (DEPTH, FOX_HEADS), jnp.float32, 0.0, 4.0),
        "gla_norm_g": 1.0 + 0.02 * nrm(ks[8], (DEPTH, GLA_V)),
        "fox_norm_g": 1.0 + 0.02 * nrm(ks[9], (DEPTH, FOX_W)),
        "w_out": nrm(ks[10], (DEPTH, MIX_W, D)) * (MIX_W ** -0.5) * DN_BETA,
        "ln1_g": 1.0 + 0.02 * nrm(ks[11], (DEPTH, D)),
        "ln1_b": 0.02 * nrm(ks[12], (DEPTH, D)),
        "peer_w_q": nrm(ks[13], (DEPTH, D, PEER_HEADS * PEER_DKEY)) * (D ** -0.5),
        "peer_sub_keys": nrm(ks[14], (DEPTH, PEER_HEADS, 2, PEER_NKEYS, PEER_DKEY // 2)) * ((PEER_DKEY // 2) ** -0.5),
        "peer_u": nrm(ks[15], (DEPTH, PEER_EXPERTS, D)) * (D ** -0.5),
        "peer_v": nrm(ks[16], (DEPTH, PEER_EXPERTS, D)) * DN_BETA * (PEER_HEADS ** -0.5),
        "ln2_g": 1.0 + 0.02 * nrm(ks[17], (DEPTH, D)),
        "ln2_b": 0.02 * nrm(ks[18], (DEPTH, D)),
    }


def reference(x, meta_tokens, emb_ln_g, emb_ln_b, w_in, w_gate_up, b_gate, b_forget, gla_norm_g,
              fox_norm_g, w_out, ln1_g, ln1_b, peer_w_q, peer_sub_keys, peer_u, peer_v, ln2_g, ln2_b):
    B = x.shape[0]
    pad = jnp.zeros((B, N_PAD, D_MODEL), x.dtype)
    meta = jnp.broadcast_to(meta_tokens[None].astype(x.dtype), (B, N_META, D_MODEL))
    h = jnp.concatenate([pad, meta, x], axis=1)
    h = layer_norm(h, emb_ln_g, emb_ln_b)
    L = h.shape[1]
    valid = jnp.arange(L) >= N_PAD
    for l in range(DEPTH):
        mix = hybrid_mixer(h, w_in[l], w_gate_up[l], b_gate[l], b_forget[l], gla_norm_g[l],
                           fox_norm_g[l], w_out[l], valid)
        h = layer_norm(DN_ALPHA * h + mix, ln1_g[l], ln1_b[l])
        ffn = peer(h, peer_w_q[l], peer_sub_keys[l], peer_u[l], peer_v[l])
        h = layer_norm(DN_ALPHA * h + ffn, ln2_g[l], ln2_b[l])
    return h[:, PREFIX:]
```

```cpp
#include <hip/hip_runtime.h>
#include <hip/hip_cooperative_groups.h>
#include <stdint.h>
#include <stdio.h>
namespace cg = cooperative_groups;

#ifndef MODE
#define MODE 1
#endif

#define DEV __device__ __forceinline__
typedef unsigned short u16;
using bf16x8 = __attribute__((ext_vector_type(8))) short;
using f32x16 = __attribute__((ext_vector_type(16))) float;
using u32x4 = __attribute__((ext_vector_type(4))) unsigned;
using u32x2 = __attribute__((ext_vector_type(2))) unsigned;
using f32x4 = __attribute__((ext_vector_type(4))) float;
using f32x2 = __attribute__((ext_vector_type(2))) float;

constexpr int DM = 1024, NB = 8, SEQ = 4096, L = 4224, T = NB * L, NPAD = 112;
constexpr int NCH = 66;
constexpr int NPROJ = 3200;
constexpr float LN_EPS = 1e-5f;
constexpr float DN_ALPHA = 1.189207115002721f;
constexpr float LOG2E = 1.4426950408889634f;
constexpr float C2 = 0.125f * LOG2E;

constexpr size_t OFF_WINT = 0;
constexpr size_t OFF_WOUTT = OFF_WINT + (size_t)NPROJ * 1024 * 2;
constexpr size_t OFF_WQT = OFF_WOUTT + (size_t)1024 * 1024 * 2;
constexpr size_t OFF_KEYS = OFF_WQT + (size_t)2048 * 1024 * 2;
constexpr size_t OFF_H0 = OFF_KEYS + (size_t)16 * 128 * 128 * 2;
constexpr size_t OFF_A = OFF_H0 + (size_t)T * 1024 * 2;
constexpr size_t A_GQ = OFF_A;
constexpr size_t A_GK = A_GQ + (size_t)NB * 4 * L * 64 * 2;
constexpr size_t A_GVT = A_GK + (size_t)NB * 4 * L * 64 * 2;
constexpr size_t A_GR = A_GVT + (size_t)NB * 4 * 128 * L * 2;
constexpr size_t A_FQ = A_GR + (size_t)T * 512 * 2;
constexpr size_t A_FK = A_FQ + (size_t)NB * 8 * L * 64 * 2;
constexpr size_t A_FVT = A_FK + (size_t)NB * 8 * L * 64 * 2;
constexpr size_t A_QAUG = A_FVT + (size_t)NB * 8 * 64 * L * 2;
constexpr size_t A_KAUG = A_QAUG + (size_t)NB * 8 * L * 16 * 2;
constexpr size_t A_GA = A_KAUG + (size_t)NB * 8 * L * 16 * 2;
constexpr size_t A_LOGF = A_GA + (size_t)T * 16 * 4;
constexpr size_t A_DEC = A_LOGF + (size_t)T * 8 * 4;
constexpr size_t A_C2 = A_DEC + (size_t)NB * 4 * NCH * 64 * 4;
constexpr size_t A_END = A_C2 + (size_t)64 * L * 4;
constexpr size_t OFF_ST = (A_END + 255) & ~(size_t)255;
constexpr size_t OFF_O = OFF_ST + (size_t)T * 1024 * 2;
constexpr size_t OFF_BAR = OFF_O + (size_t)T * 1024 * 2;
constexpr size_t OFF_TBL = OFF_BAR + 4096 + 16384;
constexpr size_t WS_END = OFF_TBL + (size_t)2 * 16384 * 768 + (size_t)2 * 16384 * 4;
constexpr int BAR_QN = 64, BAR_KN = 128, BAR_WQ = 256;
static_assert(WS_END <= (size_t)512 * 1024 * 1024, "workspace");
static_assert((size_t)NB * 4 * NCH * 128 * 64 * 4 == (size_t)T * 1024 * 2, "state size");

struct Params {
  const float *x, *meta, *eg, *eb, *w_in, *w_gu, *b_gate, *b_forget, *gng, *fng, *w_out, *ln1g, *ln1b, *wq, *subk, *pu, *pv, *ln2g, *ln2b;
  float* out; char* ws;
};

typedef unsigned v6u __attribute__((ext_vector_type(6)));
typedef float v16f __attribute__((ext_vector_type(16)));
typedef float v32f __attribute__((ext_vector_type(32)));
typedef __bf16 v32b __attribute__((ext_vector_type(32)));
typedef __bf16 v2b __attribute__((ext_vector_type(2)));
typedef unsigned v16u __attribute__((ext_vector_type(16)));
constexpr size_t TBL_U = 0, TBL_V = (size_t)16384 * 512, TBL_SC = (size_t)2 * 16384 * 512;
DEV int TIDX() { int t = (int)threadIdx.x; asm volatile("" : "+v"(t)); return t; }
typedef __bf16 bf16x2_t __attribute__((ext_vector_type(2)));
DEV unsigned cvtpk(float lo, float hi) { bf16x2_t v = {(__bf16)lo, (__bf16)hi}; return __builtin_bit_cast(unsigned, v); }
DEV u16 f2bf(float f) { return (u16)(cvtpk(f, 0.f) & 0xffffu); }
DEV float bf2f(u16 b) { return __uint_as_float(((unsigned)b) << 16); }
DEV float bflo(unsigned u) { return __uint_as_float(u << 16); }
DEV float bfhi(unsigned u) { return __uint_as_float(u & 0xffff0000u); }
DEV int crow(int r, int hh) { return (r & 3) + 8 * (r >> 2) + 4 * hh; }
DEV float wsum(float v) {
#pragma unroll
  for (int o = 32; o > 0; o >>= 1) v += __shfl_xor(v, o);
  return v;
}
DEV float logsig(float z) { return fminf(z, 0.f) - log1pf(expf(-fabsf(z))); }
#define MFMA(a, b, c) __builtin_amdgcn_mfma_f32_32x32x16_bf16(a, b, c, 0, 0, 0)
DEV bf16x8 asbf(u32x4 v) { return __builtin_bit_cast(bf16x8, v); }

DEV int winmap(int n) {
  if (n < 1536) return n;
  if (n < 3072) return n + 16;
  if (n < 3088) return 1536 + (n - 3072);
  if (n < 3096) return n;
  return -1;
}
template <bool MAP>
DEV void transpose_tile(const float* __restrict__ src, int ldsrc, u16* __restrict__ dst, int k0, int n0, char* lds) {
  float* tl = (float*)lds;
  const int tx = TIDX() & 63, ty = TIDX() >> 6;
  const int n = n0 + tx; const int on = MAP ? winmap(n) : n;
#pragma unroll
  for (int i = 0; i < 16; ++i) { const int k = ty + 4 * i; tl[k * 65 + tx] = (on >= 0) ? src[(size_t)(k0 + k) * ldsrc + on] : 0.f; }
  __syncthreads();
#pragma unroll
  for (int i = 0; i < 16; ++i) { const int nn = ty + 4 * i; dst[(size_t)(n0 + nn) * 1024 + k0 + tx] = f2bf(tl[tx * 65 + nn]); }
  __syncthreads();
}
DEV void ln_row_to_bf16(const float* src, const float* g, const float* bb, u16* dst, int lane) {
  float v[16];
  if (src) {
    const f32x4* s4 = (const f32x4*)src;
    f32x4 a0 = s4[2 * lane], a1 = s4[2 * lane + 1], b0 = s4[128 + 2 * lane], b1 = s4[128 + 2 * lane + 1];
#pragma unroll
    for (int i = 0; i < 4; ++i) { v[i] = a0[i]; v[4 + i] = a1[i]; v[8 + i] = b0[i]; v[12 + i] = b1[i]; }
  } else {
#pragma unroll
    for (int i = 0; i < 16; ++i) v[i] = 0.f;
  }
  float s = 0.f;
#pragma unroll
  for (int i = 0; i < 16; ++i) s += v[i];
  const float mu = wsum(s) * (1.f / 1024.f);
  float q = 0.f;
#pragma unroll
  for (int i = 0; i < 16; ++i) { const float d = v[i] - mu; q += d * d; }
  const float rs = rsqrtf(wsum(q) * (1.f / 1024.f) + LN_EPS);
  unsigned pk[8];
#pragma unroll
  for (int i = 0; i < 8; ++i) {
    const int e0 = (i < 4) ? (8 * lane + 2 * i) : (512 + 8 * lane + 2 * (i - 4));
    const float y0 = (v[2 * i] - mu) * rs * g[e0] + bb[e0];
    const float y1 = (v[2 * i + 1] - mu) * rs * g[e0 + 1] + bb[e0 + 1];
    pk[i] = cvtpk(y0, y1);
  }
  *(u32x4*)(dst + 8 * lane) = u32x4{pk[0], pk[1], pk[2], pk[3]};
  *(u32x4*)(dst + 512 + 8 * lane) = u32x4{pk[4], pk[5], pk[6], pk[7]};
}
DEV void phase_prep(const Params& p, char* lds) {
  u16* winT = (u16*)(p.ws + OFF_WINT); u16* woutT = (u16*)(p.ws + OFF_WOUTT); u16* wqT = (u16*)(p.ws + OFF_WQT);
  u16* keys = (u16*)(p.ws + OFF_KEYS); u16* h0 = (u16*)(p.ws + OFF_H0);
  const int n_win = 50 * 16, n_wout = 16 * 16, n_wq = 32 * 16, n_keys = 128, n_ln = T / 4;
  const int total = n_win + n_wout + n_wq + n_keys + n_ln;
  for (int it = blockIdx.x; it < total; it += gridDim.x) {
    int i = it;
    if (i < n_win) { transpose_tile<true>(p.w_in, 3096, winT, (i & 15) * 64, (i >> 4) * 64, lds); continue; }
    i -= n_win;
    if (i < n_wout) { transpose_tile<false>(p.w_out, 1024, woutT, (i & 15) * 64, (i >> 4) * 64, lds); continue; }
    i -= n_wout;
    if (i < n_wq) { transpose_tile<false>(p.wq, 2048, wqT, (i & 15) * 64, (i >> 4) * 64, lds); continue; }
    i -= n_wq;
    if (i < n_keys) {
      const size_t e = ((size_t)i * 256 + TIDX()) * 8;
      const f32x4 a = *(const f32x4*)(p.subk + e), b = *(const f32x4*)(p.subk + e + 4);
      *(u32x4*)(keys + e) = u32x4{cvtpk(a[0], a[1]), cvtpk(a[2], a[3]), cvtpk(b[0], b[1]), cvtpk(b[2], b[3])};
      continue;
    }
    i -= n_keys;
    {
      const int t = i * 4 + __builtin_amdgcn_readfirstlane(TIDX() >> 6); const int b = t / L, l = t % L;
      const float* src = (l < NPAD) ? nullptr : (l < 128 ? p.meta + (size_t)(l - NPAD) * 1024 : p.x + ((size_t)b * SEQ + (l - 128)) * 1024);
      ln_row_to_bf16(src, p.eg, p.eb, h0 + (size_t)t * 1024, TIDX() & 63);
    }
  }
}

template <int V> struct IC { static constexpr int value = V; };
template <int I, int N, class F> DEV void static_for(F&& f) { if constexpr (I < N) { f(IC<I>{}); static_for<I + 1, N>(f); } }
template <int MI>
DEV void gemm_core(const u16* __restrict__ A, int lda, const u16* __restrict__ Bt, int ldb, int K, int m0, int n0, char* lds, f32x16 (&acc)[MI][2]) {
  const int tid = TIDX(), lane = tid & 63, w = __builtin_amdgcn_readfirstlane(tid >> 6), r32 = lane & 31, hh = lane >> 5;
  const int wm = w >> 1, wn = w & 1;
  u16* As = (u16*)lds; u16* Bs = As + 64 * MI * 72;
#pragma unroll
  for (int i = 0; i < MI; ++i)
#pragma unroll
    for (int j = 0; j < 2; ++j)
#pragma unroll
      for (int r = 0; r < 16; ++r) acc[i][j][r] = 0.f;
  const int lrow = tid >> 3, lch = tid & 7;
  const u16* Ap = A + (size_t)(m0 + lrow) * lda + lch * 8;
  const u16* Bp = Bt + (size_t)(n0 + lrow) * ldb + lch * 8;
  u32x4 ra[2 * MI], rb[4];
#pragma unroll
  for (int i = 0; i < 2 * MI; ++i) ra[i] = *(const u32x4*)(Ap + (size_t)(32 * i) * lda);
#pragma unroll
  for (int i = 0; i < 4; ++i) rb[i] = *(const u32x4*)(Bp + (size_t)(32 * i) * ldb);
  const int nk = K / 64;
  for (int kt = 0; kt < nk; ++kt) {
    __syncthreads();
#pragma unroll
    for (int i = 0; i < 2 * MI; ++i) *(u32x4*)(As + (lrow + 32 * i) * 72 + lch * 8) = ra[i];
#pragma unroll
    for (int i = 0; i < 4; ++i) *(u32x4*)(Bs + (lrow + 32 * i) * 72 + lch * 8) = rb[i];
    __syncthreads();
    if (kt + 1 < nk) {
      const int k0 = (kt + 1) * 64;
#pragma unroll
      for (int i = 0; i < 2 * MI; ++i) ra[i] = *(const u32x4*)(Ap + (size_t)(32 * i) * lda + k0);
#pragma unroll
      for (int i = 0; i < 4; ++i) rb[i] = *(const u32x4*)(Bp + (size_t)(32 * i) * ldb + k0);
    }
#pragma unroll
    for (int ks = 0; ks < 4; ++ks) {
      bf16x8 a[MI], b[2];
#pragma unroll
      for (int i = 0; i < MI; ++i) a[i] = *(const bf16x8*)(As + (wm * 32 * MI + i * 32 + r32) * 72 + ks * 16 + hh * 8);
#pragma unroll
      for (int i = 0; i < 2; ++i) b[i] = *(const bf16x8*)(Bs + (wn * 64 + i * 32 + r32) * 72 + ks * 16 + hh * 8);
#pragma unroll
      for (int i = 0; i < MI; ++i)
#pragma unroll
        for (int j = 0; j < 2; ++j) acc[i][j] = MFMA(a[i], b[j], acc[i][j]);
    }
  }
}
template <int MI, class Epi>
DEV void gemm_direct_epi(f32x16 (&acc)[MI][2], int m0, int n0, Epi epi) {
  const int tid = TIDX(), lane = tid & 63, w = __builtin_amdgcn_readfirstlane(tid >> 6), r32 = lane & 31, hh = lane >> 5;
  const int wm = w >> 1, wn = w & 1;
  static_for<0, MI * 8>([&](auto idx) __attribute__((always_inline)) {
    constexpr int e = decltype(idx)::value; constexpr int i = e >> 3, j = (e >> 2) & 1, g = e & 3;
    const int row = m0 + wm * 32 * MI + i * 32 + 8 * g + 4 * hh;
    const int col = n0 + wn * 64 + j * 32 + r32;
    epi(row, col, acc[i][j][4 * g], acc[i][j][4 * g + 1], acc[i][j][4 * g + 2], acc[i][j][4 * g + 3]);
  });
}
template <int MI, class Epi>
DEV void gemm_tile(const u16* __restrict__ A, int lda, const u16* __restrict__ Bt, int ldb, int K, int m0, int n0, char* lds, Epi epi) {
  f32x16 acc[MI][2];
  gemm_core<MI>(A, lda, Bt, ldb, K, m0, n0, lds, acc);
  gemm_direct_epi<MI>(acc, m0, n0, epi);
}
DEV void gemm_stagedT_epi(f32x16 (&acc)[4][2], int m0, int c0, char* lds, u16* __restrict__ dst) {
  const int tid = TIDX(), lane = tid & 63, w = __builtin_amdgcn_readfirstlane(tid >> 6), r32 = lane & 31, hh = lane >> 5;
  const int wm = w >> 1, wn = w & 1;
  u16* Cs = (u16*)lds;
#pragma unroll 1
  for (int half = 0; half < 2; ++half) {
    __syncthreads();
    if (wn == half) {
      static_for<0, 32>([&](auto idx) __attribute__((always_inline)) {
        constexpr int e = decltype(idx)::value; constexpr int i = e >> 3, j = (e >> 2) & 1, g = e & 3;
        const int rl = wm * 128 + i * 32 + 8 * g + 4 * hh, cl = j * 32 + r32;
        *(u32x2*)(Cs + cl * 264 + rl) = u32x2{cvtpk(acc[i][j][4 * g], acc[i][j][4 * g + 1]), cvtpk(acc[i][j][4 * g + 2], acc[i][j][4 * g + 3])};
      });
    }
    __syncthreads();
#pragma unroll
    for (int q = 0; q < 8; ++q) {
      const int id = tid + 256 * q; const int cl = id >> 5, ch = id & 31;
      const int row = m0 + 8 * ch; const int b = row / L, l = row % L;
      *(u32x4*)(dst + ((size_t)(b * 512 + c0 + half * 64 + cl)) * L + l) = *(const u32x4*)(Cs + cl * 264 + 8 * ch);
    }
  }
}

DEV void phase_proj(const Params& p, char* lds) {
  const u16* h0 = (const u16*)(p.ws + OFF_H0); const u16* winT = (const u16*)(p.ws + OFF_WINT);
  u16* gq = (u16*)(p.ws + A_GQ); u16* gk = (u16*)(p.ws + A_GK); u16* gvT = (u16*)(p.ws + A_GVT); u16* gr = (u16*)(p.ws + A_GR);
  u16* fq = (u16*)(p.ws + A_FQ); u16* fk = (u16*)(p.ws + A_FK); u16* fvT = (u16*)(p.ws + A_FVT);
  float* ga = (float*)(p.ws + A_GA); float* logf = (float*)(p.ws + A_LOGF);
  const float* bfg = p.b_forget;
  const bool xa = (gridDim.x & 7) == 0;
  const int xg = blockIdx.x & 7, xq = blockIdx.x >> 3, xn = gridDim.x >> 3;
  const int ntiles = xa ? (132 * 3 + 17) : 132 * 25;
  for (int j = xa ? xq : (int)blockIdx.x; j < ntiles; j += xa ? xn : (int)gridDim.x) {
    int mt, nt;
    if (!xa) { mt = j / 25; nt = j % 25; }
    else if (j < 396) { mt = j / 3; nt = xg + 8 * (j % 3); }
    else { mt = xg + 8 * (j - 396); nt = 24; if (mt >= 132) break; }
    f32x16 acc[4][2];
    gemm_core<4>(h0, 1024, winT, 1024, 1024, mt * 256, nt * 128, lds, acc);
    if ((nt >> 2) == 1) { gemm_stagedT_epi(acc, mt * 256, (nt - 4) * 128, lds, gvT); continue; }
    if ((nt >> 2) == 5) { gemm_stagedT_epi(acc, mt * 256, (nt - 20) * 128, lds, fvT); continue; }
    gemm_direct_epi<4>(acc, mt * 256, nt * 128, [&](int row, int col, float v0, float v1, float v2, float v3) __attribute__((always_inline)) {
      const int b = row / L, l = row % L;
      const float v[4] = {v0, v1, v2, v3};
      if (col < 256) {
        const int hd = col >> 6, d = col & 63; u16* dst = gq + ((size_t)(b * 4 + hd) * L + l) * 64 + d;
#pragma unroll
        for (int i = 0; i < 4; ++i) dst[i * 64] = f2bf(v[i]);
      } else if (col < 512) {
        const int c = col - 256, hd = c >> 6, d = c & 63; u16* dst = gk + ((size_t)(b * 4 + hd) * L + l) * 64 + d;
#pragma unroll
        for (int i = 0; i < 4; ++i) dst[i * 64] = (l + i >= NPAD) ? f2bf(v[i]) : (u16)0;
      } else if (col < 1024) {
        const int c = col - 512, hd = c >> 7, vd = c & 127;
        *(u32x2*)(gvT + ((size_t)(b * 4 + hd) * 128 + vd) * L + l) = u32x2{cvtpk(v0, v1), cvtpk(v2, v3)};
      } else if (col < 1536) {
        const int c = col - 1024; u16* dst = gr + (size_t)row * 512 + c;
#pragma unroll
        for (int i = 0; i < 4; ++i) dst[i * 512] = f2bf(v[i]);
      } else if (col < 2048) {
        const int c = col - 1536, h = c >> 6, d = c & 63; u16* dst = fq + ((size_t)(b * 8 + h) * L + l) * 64 + d;
#pragma unroll
        for (int i = 0; i < 4; ++i) dst[i * 64] = f2bf(v[i] * C2);
      } else if (col < 2560) {
        const int c = col - 2048, h = c >> 6, d = c & 63; u16* dst = fk + ((size_t)(b * 8 + h) * L + l) * 64 + d;
#pragma unroll
        for (int i = 0; i < 4; ++i) dst[i * 64] = f2bf(v[i]);
      } else if (col < 3072) {
        const int c = col - 2560, h = c >> 6, d = c & 63;
        *(u32x2*)(fvT + ((size_t)(b * 8 + h) * 64 + d) * L + l) = u32x2{cvtpk(v0, v1), cvtpk(v2, v3)};
      } else {
        const int c = col - 3072;
        if (c < 16) {
#pragma unroll
          for (int i = 0; i < 4; ++i) ga[(size_t)(row + i) * 16 + c] = v[i];
        } else if (c < 24) {
          const float bf_ = bfg[c - 16];
#pragma unroll
          for (int i = 0; i < 4; ++i) logf[(size_t)(row + i) * 8 + (c - 16)] = logsig(v[i] + bf_);
        }
      }
    });
  }
}

DEV float logsig_fast(float z) { return fminf(z, 0.f) - __logf(1.f + __expf(-fabsf(z))); }
DEV void gla_gates(const Params& p, int b, int hd, int n, float* G) {
  const float* ga = (const float*)(p.ws + A_GA);
  const int tid = TIDX(), d = tid & 63, qd = __builtin_amdgcn_readfirstlane(tid >> 6);
  const int cc = hd * 64 + d;
  float wv[16];
#pragma unroll
  for (int r = 0; r < 16; ++r) wv[r] = p.w_gu[r * 256 + cc];
  const float bg = p.b_gate[cc];
  const float* gap = ga + ((size_t)b * L + 64 * n + 16 * qd) * 16;
  float v[16]; float run = 0.f;
#pragma unroll
  for (int i = 0; i < 16; ++i) {
    float z = bg;
#pragma unroll
    for (int r = 0; r < 16; ++r) z = fmaf(gap[i * 16 + r], wv[r], z);
    run += logsig_fast(z) * (1.f / 16.f); v[i] = run;
  }
  float* tot = G + 64 * 65;
  tot[qd * 64 + d] = run;
  __syncthreads();
  float off = 0.f;
  for (int k = 0; k < qd; ++k) off += tot[k * 64 + d];
#pragma unroll
  for (int i = 0; i < 16; ++i) G[(16 * qd + i) * 65 + d] = v[i] + off;
  __syncthreads();
}

DEV void gla_g1_item(const Params& p, int b, int hd, int n, char* lds) {
  float* G = (float*)lds;
  u16* KT = (u16*)(lds + 16640);
  const u16* gk = (const u16*)(p.ws + A_GK); const u16* gvT = (const u16*)(p.ws + A_GVT);
  float* st = (float*)(p.ws + OFF_ST); float* dec = (float*)(p.ws + A_DEC);
  const int tid = TIDX(), lane = tid & 63, w = __builtin_amdgcn_readfirstlane(tid >> 6), r32 = lane & 31, hh = lane >> 5;
  const int bh = b * 4 + hd;
  gla_gates(p, b, hd, n, G);
  {
    const int c = tid >> 2, dq = tid & 3;
    const u16* kr = gk + ((size_t)bh * L + 64 * n + c) * 64 + 16 * dq;
    const u32x4 k0 = *(const u32x4*)kr, k1 = *(const u32x4*)(kr + 8);
    const unsigned kk[8] = {k0[0], k0[1], k0[2], k0[3], k1[0], k1[1], k1[2], k1[3]};
#pragma unroll
    for (int j = 0; j < 16; ++j) {
      const int d = 16 * dq + j;
      const float kv = (j & 1) ? bfhi(kk[j >> 1]) : bflo(kk[j >> 1]);
      KT[d * 72 + c] = f2bf(kv * __expf(G[63 * 65 + d] - G[c * 65 + d]));
    }
    if (tid < 64) dec[((size_t)bh * NCH + n) * 64 + tid] = __expf(G[63 * 65 + tid]);
  }
  __syncthreads();
  f32x16 acc[2];
#pragma unroll
  for (int r = 0; r < 16; ++r) { acc[0][r] = 0.f; acc[1][r] = 0.f; }
  const u16* vrow = gvT + ((size_t)bh * 128 + 32 * w + r32) * L + 64 * n + 8 * hh;
#pragma unroll
  for (int ks = 0; ks < 4; ++ks) {
    const bf16x8 a = *(const bf16x8*)(vrow + 16 * ks);
#pragma unroll
    for (int dt = 0; dt < 2; ++dt) {
      const bf16x8 bb = *(const bf16x8*)(KT + (32 * dt + r32) * 72 + 16 * ks + 8 * hh);
      acc[dt] = MFMA(a, bb, acc[dt]);
    }
  }
  float* so = st + ((size_t)bh * NCH + n) * 128 * 64;
#pragma unroll
  for (int dt = 0; dt < 2; ++dt)
#pragma unroll
    for (int r = 0; r < 16; ++r) so[(size_t)(32 * w + crow(r, hh)) * 64 + 32 * dt + r32] = acc[dt][r];
  __syncthreads();
}

DEV void split3(float x, u16& a, u16& b, u16& c) {
  a = f2bf(x); float r = x - bf2f(a); b = f2bf(r); r -= bf2f(b); c = f2bf(r);
}
DEV void fox_cscan(const Params& p, int bh) {
  const float* logf = (const float*)(p.ws + A_LOGF);
  u16* qaug = (u16*)(p.ws + A_QAUG); u16* kaug = (u16*)(p.ws + A_KAUG);
  const int lane = TIDX() & 63; const int b = bh >> 3, h = bh & 7;
  float carry = 0.f;
  float lv[L / 64];
#pragma unroll
  for (int i = 0; i < L / 64; ++i) lv[i] = logf[((size_t)b * L + 64 * i + lane) * 8 + h];
#pragma unroll
  for (int i = 0; i < L / 64; ++i) {
    const int l = 64 * i + lane;
    float v = lv[i];
#pragma unroll
    for (int o = 1; o < 64; o <<= 1) { const float u = __shfl_up(v, o); if (lane >= o) v += u; }
    const float c = (carry + v) * LOG2E;
    carry += __shfl(v, 63);
    ((float*)(p.ws + A_C2))[(size_t)bh * L + l] = c;
    u16 a0, a1, a2, n0, n1, n2;
    split3(c, a0, a1, a2); split3(-c, n0, n1, n2);
    const u16 one = 0x3f80;
    u16* qa = qaug + ((size_t)bh * L + l) * 16; u16* ka = kaug + ((size_t)bh * L + l) * 16;
    *(u32x4*)qa = u32x4{(unsigned)one | ((unsigned)one << 16), (unsigned)one | ((unsigned)a0 << 16), (unsigned)a1 | ((unsigned)a2 << 16), 0u};
    *(u32x4*)(qa + 8) = u32x4{0u, 0u, 0u, 0u};
    *(u32x4*)ka = u32x4{(unsigned)n0 | ((unsigned)n1 << 16), (unsigned)n2 | ((unsigned)one << 16), (unsigned)one | ((unsigned)one << 16), 0u};
    *(u32x4*)(ka + 8) = u32x4{0u, 0u, 0u, 0u};
  }
}
DEV void fox_norms(const Params& p, int wi) {
  const int bh = wi / NCH, l = (wi % NCH) * 64 + (TIDX() & 63);
  const u16* fq = (const u16*)(p.ws + A_FQ) + ((size_t)bh * L + l) * 64; const u16* fk = (const u16*)(p.ws + A_FK) + ((size_t)bh * L + l) * 64;
  float sq = 0.f, sk = 0.f;
#pragma unroll
  for (int i = 0; i < 8; ++i) {
    const u32x4 a = *(const u32x4*)(fq + 8 * i), b = *(const u32x4*)(fk + 8 * i);
#pragma unroll
    for (int j = 0; j < 4; ++j) { sq += bflo(a[j]) * bflo(a[j]) + bfhi(a[j]) * bfhi(a[j]); sk += bflo(b[j]) * bflo(b[j]) + bfhi(b[j]) * bfhi(b[j]); }
  }
#pragma unroll
  for (int o = 32; o > 0; o >>= 1) { sq = fmaxf(sq, __shfl_xor(sq, o)); sk = fmaxf(sk, __shfl_xor(sk, o)); }
  if ((TIDX() & 63) == 0) {
    unsigned* bar = (unsigned*)(p.ws + OFF_BAR);
    atomicMax(bar + BAR_QN + bh, __float_as_uint(sq)); atomicMax(bar + BAR_KN + bh, __float_as_uint(sk));
  }
}
DEV void phase_g1(const Params& p, char* lds) {
  const int n_g1 = NB * 4 * NCH, n_cs = 16, n_nm = 64 * NCH / 4;
  for (int it = blockIdx.x; it < n_g1 + n_cs + n_nm; it += gridDim.x) {
    if (it < n_cs) fox_cscan(p, it * 4 + __builtin_amdgcn_readfirstlane(TIDX() >> 6));
    else if (it < n_cs + n_nm) fox_norms(p, (it - n_cs) * 4 + __builtin_amdgcn_readfirstlane(TIDX() >> 6));
    else { const int i = it - n_cs - n_nm; const int bh = i / NCH, n = i % NCH; gla_g1_item(p, bh >> 2, bh & 3, n, lds); }
  }
}

DEV void quant_rows(const Params& p, int wi, int lane);
DEV void phase_scan(const Params& p) {
  float* st = (float*)(p.ws + OFF_ST); const float* dec = (const float*)(p.ws + A_DEC);
  const int n_sc = NB * 4 * 8192 / 512, n_qt = 16384 / 4;
  for (int it = blockIdx.x; it < n_sc + n_qt; it += gridDim.x) {
    if (it >= n_sc) { const int tid = TIDX(); quant_rows(p, (it - n_sc) * 4 + __builtin_amdgcn_readfirstlane(tid >> 6), tid & 63); continue; }
    const int e = it * 512 + TIDX(); const int bh = e >> 13, r = e & 8191, d = r & 63;
    float* sp = st + (size_t)bh * NCH * 8192 + r; const float* dp = dec + (size_t)bh * NCH * 64 + d;
    float S0 = 0.f, S1 = 0.f;
#pragma unroll 1
    for (int n0 = 0; n0 < NCH; n0 += 11) {
      float d0[11], d1[11], dc[11];
#pragma unroll
      for (int j = 0; j < 11; ++j) { d0[j] = sp[(size_t)(n0 + j) * 8192]; d1[j] = sp[(size_t)(n0 + j) * 8192 + 256]; dc[j] = dp[(n0 + j) * 64]; }
#pragma unroll
      for (int j = 0; j < 11; ++j) { const float o0 = S0, o1 = S1; S0 = dc[j] * S0 + d0[j]; S1 = dc[j] * S1 + d1[j]; d0[j] = o0; d1[j] = o1; }
#pragma unroll
      for (int j = 0; j < 11; ++j) { sp[(size_t)(n0 + j) * 8192] = d0[j]; sp[(size_t)(n0 + j) * 8192 + 256] = d1[j]; }
    }
  }
}

DEV void gla_g3_item(const Params& p, int b, int hd, int n, char* lds) {
  float* G = (float*)lds;
  u16* QI = (u16*)(lds + 16640); u16* KI = QI + 64 * 72; u16* QD = KI + 64 * 72;
  float* part = (float*)(lds + 16640 + 3 * 9216);
  const u16* gq = (const u16*)(p.ws + A_GQ); const u16* gk = (const u16*)(p.ws + A_GK); const u16* gvT = (const u16*)(p.ws + A_GVT);
  const u16* gr = (const u16*)(p.ws + A_GR); const float* st = (const float*)(p.ws + OFF_ST); u16* o = (u16*)(p.ws + OFF_O);
  const int tid = TIDX(), lane = tid & 63, w = __builtin_amdgcn_readfirstlane(tid >> 6), r32 = lane & 31, hh = lane >> 5;
  const int bh = b * 4 + hd;
  gla_gates(p, b, hd, n, G);
  {
    const int c = tid >> 2, dq = tid & 3;
    const size_t ro = ((size_t)bh * L + 64 * n + c) * 64 + 16 * dq;
    const u32x4 q0 = *(const u32x4*)(gq + ro), q1 = *(const u32x4*)(gq + ro + 8), k0 = *(const u32x4*)(gk + ro), k1 = *(const u32x4*)(gk + ro + 8);
    const unsigned qq[8] = {q0[0], q0[1], q0[2], q0[3], q1[0], q1[1], q1[2], q1[3]};
    const unsigned kk[8] = {k0[0], k0[1], k0[2], k0[3], k1[0], k1[1], k1[2], k1[3]};
    unsigned oqi[8], oki[8], oqd[8];
#pragma unroll
    for (int j2 = 0; j2 < 8; ++j2) {
      float qi[2], ki[2], qd[2];
#pragma unroll
      for (int e = 0; e < 2; ++e) {
        const int d = 16 * dq + 2 * j2 + e;
        const float qv = e ? bfhi(qq[j2]) : bflo(qq[j2]); const float kv = e ? bfhi(kk[j2]) : bflo(kk[j2]);
        const float bc = G[c * 65 + d], br = G[31 * 65 + d];
        qi[e] = qv * __expf(bc - br) * 0.125f; ki[e] = kv * __expf(br - bc); qd[e] = qv * __expf(bc) * 0.125f;
      }
      oqi[j2] = cvtpk(qi[0], qi[1]); oki[j2] = cvtpk(ki[0], ki[1]); oqd[j2] = cvtpk(qd[0], qd[1]);
    }
    *(u32x4*)(QI + c * 72 + 16 * dq) = u32x4{oqi[0], oqi[1], oqi[2], oqi[3]}; *(u32x4*)(QI + c * 72 + 16 * dq + 8) = u32x4{oqi[4], oqi[5], oqi[6], oqi[7]};
    *(u32x4*)(KI + c * 72 + 16 * dq) = u32x4{oki[0], oki[1], oki[2], oki[3]}; *(u32x4*)(KI + c * 72 + 16 * dq + 8) = u32x4{oki[4], oki[5], oki[6], oki[7]};
    *(u32x4*)(QD + c * 72 + 16 * dq) = u32x4{oqd[0], oqd[1], oqd[2], oqd[3]}; *(u32x4*)(QD + c * 72 + 16 * dq + 8) = u32x4{oqd[4], oqd[5], oqd[6], oqd[7]};
  }
  __syncthreads();
  f32x16 at[2][2];
#pragma unroll
  for (int i = 0; i < 2; ++i)
#pragma unroll
    for (int j = 0; j < 2; ++j)
#pragma unroll
      for (int r = 0; r < 16; ++r) at[i][j][r] = 0.f;
#pragma unroll
  for (int ks = 0; ks < 4; ++ks) {
    bf16x8 ka[2], qb[2];
#pragma unroll
    for (int i = 0; i < 2; ++i) { ka[i] = *(const bf16x8*)(KI + (32 * i + r32) * 72 + 16 * ks + 8 * hh); qb[i] = *(const bf16x8*)(QI + (32 * i + r32) * 72 + 16 * ks + 8 * hh); }
#pragma unroll
    for (int i = 0; i < 2; ++i)
#pragma unroll
      for (int j = 0; j < 2; ++j) at[i][j] = MFMA(ka[i], qb[j], at[i][j]);
  }
  unsigned pw[2][2][8];
#pragma unroll
  for (int stt = 0; stt < 2; ++stt)
#pragma unroll
    for (int ct = 0; ct < 2; ++ct)
#pragma unroll
      for (int r2 = 0; r2 < 8; ++r2) {
        const int s0 = 32 * stt + crow(2 * r2, hh), cc = 32 * ct + r32;
        const float v0 = (s0 <= cc) ? at[stt][ct][2 * r2] : 0.f, v1 = (s0 + 1 <= cc) ? at[stt][ct][2 * r2 + 1] : 0.f;
        pw[stt][ct][r2] = cvtpk(v0, v1);
      }
  f32x16 oa[2];
#pragma unroll
  for (int r = 0; r < 16; ++r) { oa[0][r] = 0.f; oa[1][r] = 0.f; }
  const u16* vrow = gvT + ((size_t)bh * 128 + 32 * w + r32) * L + 64 * n;
#pragma unroll
  for (int stt = 0; stt < 2; ++stt)
#pragma unroll
    for (int s2 = 0; s2 < 2; ++s2) {
      const u32x2 lo = *(const u32x2*)(vrow + 32 * stt + 16 * s2 + 4 * hh), hi = *(const u32x2*)(vrow + 32 * stt + 16 * s2 + 8 + 4 * hh);
      const bf16x8 vf = asbf(u32x4{lo[0], lo[1], hi[0], hi[1]});
#pragma unroll
      for (int ct = 0; ct < 2; ++ct) {
        const bf16x8 pf = asbf(u32x4{pw[stt][ct][4 * s2], pw[stt][ct][4 * s2 + 1], pw[stt][ct][4 * s2 + 2], pw[stt][ct][4 * s2 + 3]});
        oa[ct] = MFMA(vf, pf, oa[ct]);
      }
    }
  const float* srow = st + (((size_t)bh * NCH + n) * 128 + 32 * w + r32) * 64 + 8 * hh;
#pragma unroll
  for (int ks = 0; ks < 4; ++ks) {
    const f32x4 s0 = *(const f32x4*)(srow + 16 * ks), s1 = *(const f32x4*)(srow + 16 * ks + 4);
    const bf16x8 sf = asbf(u32x4{cvtpk(s0[0], s0[1]), cvtpk(s0[2], s0[3]), cvtpk(s1[0], s1[1]), cvtpk(s1[2], s1[3])});
#pragma unroll
    for (int ct = 0; ct < 2; ++ct) {
      const bf16x8 qf = *(const bf16x8*)(QD + (32 * ct + r32) * 72 + 16 * ks + 8 * hh);
      oa[ct] = MFMA(sf, qf, oa[ct]);
    }
  }
#pragma unroll
  for (int ct = 0; ct < 2; ++ct) { float s = 0.f;
#pragma unroll
    for (int r = 0; r < 16; ++r) s += oa[ct][r] * oa[ct][r];
    part[(2 * w + hh) * 64 + 32 * ct + r32] = s; }
  __syncthreads();
#pragma unroll
  for (int ct = 0; ct < 2; ++ct) {
    const int c = 32 * ct + r32; float tot = 0.f;
#pragma unroll
    for (int i = 0; i < 8; ++i) tot += part[i * 64 + c];
    const float rn = rsqrtf(tot * (1.f / 128.f) + LN_EPS);
    const size_t t = (size_t)b * L + 64 * n + c;
#pragma unroll
    for (int g = 0; g < 4; ++g) {
      const int vd = 32 * w + 8 * g + 4 * hh; const int cc = hd * 128 + vd;
      const u32x2 rr = *(const u32x2*)(gr + t * 512 + cc);
      const float rv[4] = {bflo(rr[0]), bfhi(rr[0]), bflo(rr[1]), bfhi(rr[1])};
      float ov[4];
#pragma unroll
      for (int i = 0; i < 4; ++i) { const float sl = rv[i] / (1.f + __expf(-rv[i])); ov[i] = oa[ct][4 * g + i] * rn * p.gng[cc + i] * sl; }
      *(u32x2*)(o + t * 1024 + cc) = u32x2{cvtpk(ov[0], ov[1]), cvtpk(ov[2], ov[3])};
    }
  }
  __syncthreads();
}

DEV void fox_attn_item(const Params& p, int b, int h, int qb, char* lds) {
  u16* Ks = (u16*)lds;
  u16* Ka = Ks + 64 * 72;
  u16* Vs = Ka + 64 * 24;
  const int tid = TIDX(), lane = tid & 63, w = __builtin_amdgcn_readfirstlane(tid >> 6), r32 = lane & 31, hh = lane >> 5;
  const size_t bh = (size_t)b * 8 + h;
  const u16* fq = (const u16*)(p.ws + A_FQ) + bh * L * 64; const u16* fk = (const u16*)(p.ws + A_FK) + bh * L * 64;
  const u16* fvT = (const u16*)(p.ws + A_FVT) + bh * 64 * L;
  const u16* qaug = (const u16*)(p.ws + A_QAUG) + bh * L * 16; const u16* kaug = (const u16*)(p.ws + A_KAUG) + bh * L * 16;
  u16* o = (u16*)(p.ws + OFF_O);
  const int ql = 128 * qb + 32 * w + r32;
  bf16x8 qf[5];
#pragma unroll
  for (int d0 = 0; d0 < 4; ++d0) qf[d0] = *(const bf16x8*)(fq + (size_t)ql * 64 + 16 * d0 + 8 * hh);
  qf[4] = *(const bf16x8*)(qaug + (size_t)ql * 16 + 8 * hh);
  f32x16 o0, o1;
#pragma unroll
  for (int r = 0; r < 16; ++r) { o0[r] = 0.f; o1[r] = 0.f; }
  float m = -1e30f, lsum = 0.f;
  const int wqmin = 128 * qb + 32 * w, wqmax = wqmin + 31;
  const int kt_hi = 2 * qb + 1, kt_lo = 1;
  u32x4 rk[2], rv[2], rka;
  const int krow = tid >> 3, kch = tid & 7;
  volatile int* doneflag = (volatile int*)(lds + 55296 + 16);
  const float* c2p = (const float*)(p.ws + A_C2) + bh * L;
  const unsigned* bar = (const unsigned*)(p.ws + OFF_BAR);
  const float U = sqrtf(__uint_as_float(bar[BAR_QN + bh]) * __uint_as_float(bar[BAR_KN + bh]));
  const float cqb = c2p[128 * qb];
  int mydone = 0;
  auto gload = [&](int kt) {
#pragma unroll
    for (int i = 0; i < 2; ++i) {
      rk[i] = *(const u32x4*)(fk + (size_t)(64 * kt + krow + 32 * i) * 64 + 8 * kch);
      rv[i] = *(const u32x4*)(fvT + (size_t)(krow + 32 * i) * L + 64 * kt + 8 * kch);
    }
    if (tid < 128) rka = *(const u32x4*)(kaug + (size_t)(64 * kt + (tid >> 1)) * 16 + 8 * (tid & 1));
  };
  gload(kt_hi);
  for (int kt = kt_hi; kt >= kt_lo; --kt) {
    if (!mydone && kt < 2 * qb) {
      float mm = m;
#pragma unroll
      for (int o = 16; o > 0; o >>= 1) mm = fminf(mm, __shfl_xor(mm, o));
      if (cqb - c2p[64 * kt + 63] + U < mm - 40.f) mydone = 1;
    }
    if (lane == 0) doneflag[w] = mydone;
    __syncthreads();
    if (doneflag[0] + doneflag[1] + doneflag[2] + doneflag[3] == 4) break;
#pragma unroll
    for (int i = 0; i < 2; ++i) {
      *(u32x4*)(Ks + (krow + 32 * i) * 72 + 8 * kch) = rk[i];
      u16* vd = Vs + (krow + 32 * i) * 68 + 8 * kch;
      *(u32x2*)vd = u32x2{rv[i][0], rv[i][1]}; *(u32x2*)(vd + 4) = u32x2{rv[i][2], rv[i][3]};
    }
    if (tid < 128) { u16* kd = Ka + (tid >> 1) * 24 + 8 * (tid & 1); *(u32x4*)kd = rka; }
    __syncthreads();
    if (kt > kt_lo) gload(kt - 1);
    if (64 * kt <= wqmax && !mydone) {
      f32x16 s0, s1;
#pragma unroll
      for (int r = 0; r < 16; ++r) { s0[r] = 0.f; s1[r] = 0.f; }
#pragma unroll
      for (int d0 = 0; d0 < 4; ++d0) {
        const bf16x8 k0 = *(const bf16x8*)(Ks + r32 * 72 + 16 * d0 + 8 * hh), k1 = *(const bf16x8*)(Ks + (32 + r32) * 72 + 16 * d0 + 8 * hh);
        s0 = MFMA(k0, qf[d0], s0); s1 = MFMA(k1, qf[d0], s1);
      }
      {
        const bf16x8 k0 = *(const bf16x8*)(Ka + r32 * 24 + 8 * hh), k1 = *(const bf16x8*)(Ka + (32 + r32) * 24 + 8 * hh);
        s0 = MFMA(k0, qf[4], s0); s1 = MFMA(k1, qf[4], s1);
      }
      if (kt == 1 || 64 * kt + 63 > wqmin) {
#pragma unroll
        for (int r = 0; r < 16; ++r) {
          const int k0 = 64 * kt + crow(r, hh), k1 = k0 + 32;
          if (!(k0 <= ql && k0 >= NPAD)) s0[r] = -1e30f;
          if (!(k1 <= ql && k1 >= NPAD)) s1[r] = -1e30f;
        }
      }
      float rm = fmaxf(s0[0], s1[0]);
#pragma unroll
      for (int r = 1; r < 16; ++r) rm = fmaxf(rm, fmaxf(s0[r], s1[r]));
      rm = fmaxf(rm, __shfl_xor(rm, 32));
      const float mn = fmaxf(m, rm); const float alpha = __builtin_amdgcn_exp2f(m - mn); m = mn;
      float ps = 0.f;
#pragma unroll
      for (int r = 0; r < 16; ++r) { s0[r] = __builtin_amdgcn_exp2f(s0[r] - mn); s1[r] = __builtin_amdgcn_exp2f(s1[r] - mn); ps += s0[r] + s1[r]; }
      lsum = lsum * alpha + ps;
#pragma unroll
      for (int r = 0; r < 16; ++r) { o0[r] *= alpha; o1[r] *= alpha; }
      unsigned pw0[8], pw1[8];
#pragma unroll
      for (int i = 0; i < 8; ++i) { pw0[i] = cvtpk(s0[2 * i], s0[2 * i + 1]); pw1[i] = cvtpk(s1[2 * i], s1[2 * i + 1]); }
#pragma unroll
      for (int nk = 0; nk < 2; ++nk)
#pragma unroll
        for (int s2 = 0; s2 < 2; ++s2) {
          const bf16x8 pf = nk ? asbf(u32x4{pw1[4 * s2], pw1[4 * s2 + 1], pw1[4 * s2 + 2], pw1[4 * s2 + 3]}) : asbf(u32x4{pw0[4 * s2], pw0[4 * s2 + 1], pw0[4 * s2 + 2], pw0[4 * s2 + 3]});
          {
            const u16* vb = Vs + r32 * 68 + 32 * nk + 16 * s2 + 4 * hh;
            const u32x2 lo = *(const u32x2*)vb, hi = *(const u32x2*)(vb + 8);
            o0 = MFMA(asbf(u32x4{lo[0], lo[1], hi[0], hi[1]}), pf, o0);
          }
          {
            const u16* vb = Vs + (32 + r32) * 68 + 32 * nk + 16 * s2 + 4 * hh;
            const u32x2 lo = *(const u32x2*)vb, hi = *(const u32x2*)(vb + 8);
            o1 = MFMA(asbf(u32x4{lo[0], lo[1], hi[0], hi[1]}), pf, o1);
          }
        }
    }
  }
  const float ltot = lsum + __shfl_xor(lsum, 32); const float inv = 1.f / ltot;
  float ssq = 0.f;
#pragma unroll
  for (int r = 0; r < 16; ++r) { o0[r] *= inv; o1[r] *= inv; ssq += o0[r] * o0[r] + o1[r] * o1[r]; }
  ssq += __shfl_xor(ssq, 32);
  const float rn = rsqrtf(ssq * (1.f / 64.f) + LN_EPS);
  const size_t t = (size_t)b * L + ql;
#pragma unroll
  for (int dt = 0; dt < 2; ++dt)
#pragma unroll
    for (int g = 0; g < 4; ++g) {
      const int d = 32 * dt + 8 * g + 4 * hh; const int cc = h * 64 + d;
      float ov[4];
#pragma unroll
      for (int i = 0; i < 4; ++i) ov[i] = (dt ? o1[4 * g + i] : o0[4 * g + i]) * rn * p.fng[cc + i];
      *(u32x2*)(o + t * 1024 + 512 + cc) = u32x2{cvtpk(ov[0], ov[1]), cvtpk(ov[2], ov[3])};
    }
  __syncthreads();
}
DEV int next_item(unsigned* ctr, volatile int* slot) {
  __syncthreads();
  if (TIDX() == 0) *slot = (int)atomicAdd(ctr, 1u);
  __syncthreads();
  return *slot;
}
DEV void phase_mix(const Params& p0, char* lds) {
  const int n_at = NB * 8 * 32, n_g3 = NB * 4 * 64;
  volatile int* slot = (volatile int*)(lds + 55296);
  {
    Params p = p0; { size_t z = 0; asm volatile("" : "+s"(z) :: "memory"); p.ws = p0.ws + z; }
    unsigned* ctr = (unsigned*)(p.ws + OFF_BAR) + BAR_WQ;
#pragma unroll 1
    for (int it = next_item(ctr, slot); it < n_at; it = next_item(ctr, slot)) { const int qb = 32 - (it >> 6), bh = it & 63; fox_attn_item(p, bh >> 3, bh & 7, qb, lds); }
  }
  {
    Params p = p0; { size_t z = 0; asm volatile("" : "+s"(z) :: "memory"); p.ws = p0.ws + z; }
    unsigned* ctr = (unsigned*)(p.ws + OFF_BAR) + BAR_WQ + 1;
#pragma unroll 1
    for (int i = next_item(ctr, slot); i < n_g3; i = next_item(ctr, slot)) { const int bh = i >> 6, n = 2 + (i & 63); gla_g3_item(p, bh >> 2, bh & 3, n, lds); }
  }
}

DEV int real_mtile(int i) { return (i >> 5) * 33 + 1 + (i & 31); }
DEV int real_m0(int i) { return (i >> 4) * L + 128 + (i & 15) * 256; }
DEV void phase_outproj(const Params& p, char* lds) {
  const u16* o = (const u16*)(p.ws + OFF_O); const u16* woutT = (const u16*)(p.ws + OFF_WOUTT); const u16* h0 = (const u16*)(p.ws + OFF_H0);
  float* pre1 = (float*)(p.ws + OFF_A);
  for (int tile = blockIdx.x; tile < 128 * 8; tile += gridDim.x) {
    const int m0 = real_m0(tile >> 3), nt = tile & 7;
    gemm_tile<4>(o, 1024, woutT, 1024, 1024, m0, nt * 128, lds, [&](int row, int col, float v0, float v1, float v2, float v3) __attribute__((always_inline)) {
      const float v[4] = {v0, v1, v2, v3};
#pragma unroll
      for (int i = 0; i < 4; ++i) { const size_t e = (size_t)(row + i) * 1024 + col; pre1[e] = DN_ALPHA * bf2f(h0[e]) + v[i]; }
    });
  }
}

DEV void quant_rows(const Params& p, int wi, int lane) {
  unsigned char* tq = (unsigned char*)(p.ws + OFF_TBL); float* tsc = (float*)(p.ws + OFF_TBL + TBL_SC);
  const int r = 2 * wi + (lane >> 5); const int c = lane & 31;
  const float* src = ((r < 16384) ? p.pu + (size_t)r * 1024 : p.pv + (size_t)(r - 16384) * 1024) + 32 * c;
  v16f a, b;
#pragma unroll
  for (int i = 0; i < 4; ++i) {
    const f32x4 x0 = *(const f32x4*)(src + 4 * i), x1 = *(const f32x4*)(src + 16 + 4 * i);
#pragma unroll
    for (int j = 0; j < 4; ++j) { a[4 * i + j] = x0[j]; b[4 * i + j] = x1[j]; }
  }
  float am = 0.f;
#pragma unroll
  for (int i = 0; i < 16; ++i) am = fmaxf(am, fmaxf(fabsf(a[i]), fabsf(b[i])));
#pragma unroll
  for (int o = 16; o > 0; o >>= 1) am = fmaxf(am, __shfl_xor(am, o));
  const float sc = (am > 0.f) ? am * (1.f / 7.5f) : 1.f; const float isc = 1.f / sc;
#pragma unroll
  for (int i = 0; i < 16; ++i) { a[i] *= isc; b[i] *= isc; }
  {
    const float k4 = 6.f / 7.5f;
    unsigned p4[4] = {0u, 0u, 0u, 0u};
    static_for<0, 32>([&](auto ix) __attribute__((always_inline)) {
      constexpr int i = decltype(ix)::value;
      const float v = ((i < 16) ? a[i & 15] : b[i & 15]) * k4;
      const float av = fabsf(v);
      const unsigned code = (unsigned)(av > 0.25f) + (unsigned)(av > 0.75f) + (unsigned)(av > 1.25f) + (unsigned)(av > 1.75f) + (unsigned)(av > 2.5f) + (unsigned)(av > 3.5f) + (unsigned)(av > 5.f);
      p4[i >> 3] |= (code | ((v < 0.f) ? 8u : 0u)) << (4 * (i & 7));
    });
    *(u32x4*)(tq + (size_t)r * 512 + 16 * c) = u32x4{p4[0], p4[1], p4[2], p4[3]};
    if (c == 0) tsc[r] = sc * (7.5f / 6.f);
    return;
  }
  unsigned pk[6] = {0u, 0u, 0u, 0u, 0u, 0u};
  static_for<0, 32>([&](auto ix) __attribute__((always_inline)) {
    constexpr int i = decltype(ix)::value;
    const float v = (i < 16) ? a[i & 15] : b[i & 15];
    const float av = fabsf(v);
    float cf = (av < 2.f) ? av * 8.f : ((av < 4.f) ? 16.f + (av - 2.f) * 4.f : 24.f + (av - 4.f) * 2.f);
    unsigned code = (unsigned)(int)rintf(cf); code = code > 31u ? 31u : code;
    const unsigned f = code | ((v < 0.f) ? 32u : 0u);
    constexpr int bp = 6 * i, di = bp >> 5, off = bp & 31;
    pk[di] |= f << off;
    if constexpr (off > 26) pk[di + 1] |= f >> (32 - off);
  });
  u32x2* dst = (u32x2*)(tq + TBL_V + (size_t)(r - 16384) * 768 + 24 * c);
  dst[0] = u32x2{pk[0], pk[1]}; dst[1] = u32x2{pk[2], pk[3]}; dst[2] = u32x2{pk[4], pk[5]};
  if (c == 0) tsc[r] = sc;
}
DEV void phase_ln1(const Params& p) {
  const float* pre1 = (const float*)(p.ws + OFF_A); u16* h1 = (u16*)(p.ws + OFF_ST);
  const int tid = TIDX(); const int lane = tid & 63, wv = __builtin_amdgcn_readfirstlane(tid >> 6);
  for (int it = blockIdx.x; it < 32768 / 4; it += gridDim.x) {
    const int ti = it * 4 + wv; const int t = (ti >> 12) * L + 128 + (ti & 4095);
    ln_row_to_bf16(pre1 + (size_t)t * 1024, p.ln1g, p.ln1b, h1 + (size_t)t * 1024, lane);
  }
}

DEV void phase_peerq(const Params& p, char* lds) {
  const u16* h1 = (const u16*)(p.ws + OFF_ST); const u16* wqT = (const u16*)(p.ws + OFF_WQT); u16* qp = (u16*)(p.ws + OFF_A);
  const bool xa = (gridDim.x & 7) == 0;
  for (int tile = blockIdx.x; tile < 128 * 16; tile += gridDim.x) {
    const int mt_ = xa ? (tile >> 4) : (tile >> 4), nt = xa ? ((tile & 7) + 8 * ((tile >> 3) & 1)) : (tile & 15);
    const int m0 = real_m0(mt_);
    gemm_tile<4>(h1, 1024, wqT, 1024, 1024, m0, nt * 128, lds, [&](int row, int col, float v0, float v1, float v2, float v3) __attribute__((always_inline)) {
      u16* dst = qp + (size_t)row * 2048 + col;
      dst[0] = f2bf(v0); dst[2048] = f2bf(v1); dst[4096] = f2bf(v2); dst[6144] = f2bf(v3);
    });
  }
}

DEV unsigned fkey(float f) { const unsigned u = __float_as_uint(f); return (u & 0x80000000u) ? ~u : (u | 0x80000000u); }
DEV float kval(unsigned k) { const unsigned u = (k & 0x80000000u) ? (k & 0x7fffffffu) : ~k; return __uint_as_float(u); }
DEV void ins16(unsigned (&Lst)[16], unsigned x) {
#pragma unroll
  for (int i = 0; i < 16; ++i) { const unsigned hi = max(Lst[i], x); x = min(Lst[i], x); Lst[i] = hi; }
}
DEV void cswap_desc(unsigned& a, unsigned& b) { const unsigned hi = max(a, b), lo = min(a, b); a = hi; b = lo; }
template <int K, int J> DEV void bstage(unsigned (&a)[16]) {
  static_for<0, 16>([&](auto ix) __attribute__((always_inline)) {
    constexpr int i = decltype(ix)::value; constexpr int l = i ^ J;
    if constexpr (l > i) {
      const unsigned hi = max(a[i], a[l]), lo = min(a[i], a[l]);
      if constexpr ((i & K) == 0) { a[i] = hi; a[l] = lo; } else { a[i] = lo; a[l] = hi; }
    }
  });
}
DEV void sort16_desc(unsigned (&a)[16]) {
  bstage<2, 1>(a); bstage<4, 2>(a); bstage<4, 1>(a); bstage<8, 4>(a); bstage<8, 2>(a); bstage<8, 1>(a);
  bstage<16, 8>(a); bstage<16, 4>(a); bstage<16, 2>(a); bstage<16, 1>(a);
}
DEV void merge16_desc(unsigned (&a)[16], const unsigned (&b)[16]) {
#pragma unroll
  for (int i = 0; i < 16; ++i) a[i] = max(a[i], b[15 - i]);
  bstage<16, 8>(a); bstage<16, 4>(a); bstage<16, 2>(a); bstage<16, 1>(a);
}
constexpr int C1I[16] = {1, 1, 1, 1, 1, 1, 1, 1, 2, 2, 2, 2, 2, 4, 4, 4}, C1J[16] = {0, 1, 2, 3, 4, 5, 6, 7, 0, 1, 2, 3, 4, 0, 1, 2};
constexpr int C2I[16] = {3, 3, 3, 3, 5, 5, 6, 6, 7, 7, 8, 9, 10, 11, 12, 13}, C2J[16] = {0, 1, 2, 3, 0, 1, 0, 1, 0, 1, 0, 0, 0, 0, 0, 0};
DEV void phase_topk(const Params& p, char* lds) {
  u16* KS = (u16*)lds;
  const u16* keys = (const u16*)(p.ws + OFF_KEYS); const u16* qp = (const u16*)(p.ws + OFF_A);
  int* experts = (int*)(p.ws + OFF_O); float* gates = (float*)(p.ws + OFF_O + (size_t)T * 128 * 4);
  const int tid = TIDX(), lane = tid & 63, w = __builtin_amdgcn_readfirstlane(tid >> 6), r32 = lane & 31, hh = lane >> 5;
  u32x4 kreg[8];
  auto kload = [&](int hc) __attribute__((always_inline)) {
#pragma unroll
    for (int i = 0; i < 8; ++i) { const int id = tid + 256 * i; const int row = id >> 4, ch = id & 15;
      kreg[i] = *(const u32x4*)(keys + ((size_t)hc * 128 + row) * 128 + 8 * ch); }
  };
  if ((int)blockIdx.x < 2048) kload(2 * ((int)blockIdx.x & 7));
#pragma unroll 1
  for (int it = blockIdx.x; it < 2048; it += gridDim.x) {
    const int m0 = real_mtile(it >> 3) * 128; const size_t t = (size_t)m0 + 32 * w + r32;
    const int h = it & 7;
    {
      unsigned LA[16], LB[16];
#pragma unroll
      for (int i = 0; i < 16; ++i) { LA[i] = 0u; LB[i] = 0u; }
#pragma unroll 1
      for (int c = 0; c < 2; ++c) {
        const int hc = 2 * h + c;
        const u16* qrow = qp + t * 2048 + hc * 128 + 8 * hh;
        bf16x8 qf[8];
#pragma unroll
        for (int ks = 0; ks < 8; ++ks) qf[ks] = *(const bf16x8*)(qrow + 16 * ks);
        __syncthreads();
#pragma unroll
        for (int i = 0; i < 8; ++i) { const int id = tid + 256 * i; const int row = id >> 4, ch = id & 15;
          *(u32x4*)(KS + row * 136 + 8 * ch) = kreg[i]; }
        __syncthreads();
        { const int nit = it + (int)gridDim.x; if (c == 0) kload(hc + 1); else if (nit < 2048) kload(2 * (nit & 7)); }
        unsigned Lc[16];
#pragma unroll
        for (int i = 0; i < 16; ++i) Lc[i] = 0u;
#pragma unroll 1
        for (int kt = 0; kt < 4; ++kt) {
          f32x16 acc;
#pragma unroll
          for (int r = 0; r < 16; ++r) acc[r] = 0.f;
#pragma unroll
          for (int ks = 0; ks < 8; ++ks) acc = MFMA(*(const bf16x8*)(KS + (32 * kt + r32) * 136 + 16 * ks + 8 * hh), qf[ks], acc);
          unsigned kb[16];
#pragma unroll
          for (int r = 0; r < 16; ++r) kb[r] = (fkey(acc[r]) & ~127u) | (unsigned)(32 * kt + crow(r, hh));
          sort16_desc(kb);
          merge16_desc(Lc, kb);
        }
        unsigned M[16];
#pragma unroll
        for (int i = 0; i < 16; ++i) M[i] = max(Lc[i], (unsigned)__shfl_xor((int)Lc[15 - i], 32));
        bstage<16, 8>(M); bstage<16, 4>(M); bstage<16, 2>(M); bstage<16, 1>(M);
#pragma unroll
        for (int i = 0; i < 16; ++i) { LA[i] = LB[i]; LB[i] = M[i]; }
      }
      unsigned H2[16], Hb[16];
      {
        float fa[16], fb[16];
#pragma unroll
        for (int i = 0; i < 16; ++i) { fa[i] = kval(LA[i] & ~127u); fb[i] = kval(LB[i] & ~127u); }
#pragma unroll
        for (int j = 0; j < 16; ++j) H2[j] = (fkey(fa[0] + fb[j]) & ~255u) | (unsigned)j;
        sort16_desc(H2);
        static_for<0, 16>([&](auto ix) __attribute__((always_inline)) { constexpr int e = decltype(ix)::value; constexpr int i = C1I[e], j = C1J[e];
          Hb[e] = (fkey(fa[i] + fb[j]) & ~255u) | (unsigned)(i * 16 + j); });
        sort16_desc(Hb); merge16_desc(H2, Hb);
        static_for<0, 16>([&](auto ix) __attribute__((always_inline)) { constexpr int e = decltype(ix)::value; constexpr int i = C2I[e], j = C2J[e];
          Hb[e] = (fkey(fa[i] + fb[j]) & ~255u) | (unsigned)(i * 16 + j); });
        sort16_desc(Hb); merge16_desc(H2, Hb);
        ins16(H2, (fkey(fa[14] + fb[0]) & ~255u) | (unsigned)(14 * 16));
        ins16(H2, (fkey(fa[15] + fb[0]) & ~255u) | (unsigned)(15 * 16));
      }
      unsigned char* tab = (unsigned char*)(lds + 34816) + (w * 32 + r32) * 32;
      if (hh == 0) {
        unsigned pk[8];
#pragma unroll
        for (int i = 0; i < 4; ++i) {
          pk[i] = (LA[4 * i] & 127u) | ((LA[4 * i + 1] & 127u) << 8) | ((LA[4 * i + 2] & 127u) << 16) | ((LA[4 * i + 3] & 127u) << 24);
          pk[4 + i] = (LB[4 * i] & 127u) | ((LB[4 * i + 1] & 127u) << 8) | ((LB[4 * i + 2] & 127u) << 16) | ((LB[4 * i + 3] & 127u) << 24);
        }
        *(u32x4*)tab = u32x4{pk[0], pk[1], pk[2], pk[3]}; *(u32x4*)(tab + 16) = u32x4{pk[4], pk[5], pk[6], pk[7]};
      }
      const float mx = kval(H2[0] & ~255u); float Z = 0.f;
#pragma unroll
      for (int i = 0; i < 16; ++i) Z += __expf(kval(H2[i] & ~255u) - mx);
      const float iz = 1.f / Z;
      int eo[8]; float go[8];
#pragma unroll
      for (int i = 0; i < 8; ++i) {
        const unsigned sel = hh ? 0xffffffffu : 0u;
        const unsigned key = (H2[8 + i] & sel) | (H2[i] & ~sel);
        const unsigned cid = key & 255u;
        eo[i] = (int)tab[cid >> 4] * 128 + (int)tab[16 + (cid & 15u)];
        go[i] = __expf(kval(key & ~255u) - mx) * iz;
      }
      int* ed = experts + t * 128 + h * 16 + 8 * hh; float* gd = gates + t * 128 + h * 16 + 8 * hh;
      *(u32x4*)ed = u32x4{(unsigned)eo[0], (unsigned)eo[1], (unsigned)eo[2], (unsigned)eo[3]}; *(u32x4*)(ed + 4) = u32x4{(unsigned)eo[4], (unsigned)eo[5], (unsigned)eo[6], (unsigned)eo[7]};
      *(f32x4*)gd = f32x4{go[0], go[1], go[2], go[3]}; *(f32x4*)(gd + 4) = f32x4{go[4], go[5], go[6], go[7]};
    }
  }
}

DEV v32f swdec(const v6u& d) {
  v32f o;
  static_for<0, 32>([&](auto ix) __attribute__((always_inline)) {
    constexpr int i = decltype(ix)::value; constexpr int bp = 6 * i, di = bp >> 5, off = bp & 31;
    unsigned f = d[di] >> off;
    if constexpr (off > 26) f |= d[di + 1] << (32 - off);
    f &= 63u;
    const unsigned code = f & 31u; const unsigned e = code >> 3, m = code & 7u;
    float v = (e == 0) ? (float)m * 0.125f : (1.f + (float)m * 0.125f) * (float)(1u << (e - 1));
    o[i] = (f & 32u) ? -v : v;
  });
  return o;
}
DEV v6u ld_row(const unsigned char* p) { const u32x2* q = (const u32x2*)p; const u32x2 a = q[0], b = q[1], c = q[2]; return v6u{a[0], a[1], b[0], b[1], c[0], c[1]}; }
DEV void phase_experts(const Params& p) {
  const u16* h1 = (const u16*)(p.ws + OFF_ST);
  const unsigned char* uq = (const unsigned char*)(p.ws + OFF_TBL + TBL_U); const unsigned char* vq = (const unsigned char*)(p.ws + OFF_TBL + TBL_V);
  const float* tsc = (const float*)(p.ws + OFF_TBL + TBL_SC);
  const int* experts = (const int*)(p.ws + OFF_O); const float* gates = (const float*)(p.ws + OFF_O + (size_t)T * 128 * 4);
  const int tid_ = TIDX(); const int lane = tid_ & 63, w = __builtin_amdgcn_readfirstlane(tid_ >> 6);
  const int c = lane & 31; const bool hi = lane >= 32;
  const int b4 = (lane >> 4) & 1, b3 = (lane >> 3) & 1, b2 = (lane >> 2) & 1, b1 = (lane >> 1) & 1;
  const int kofs = 2 * ((lane >> 1) & 15) + (lane >> 5);
  for (int ti = blockIdx.x * 4 + w; ti < 32768; ti += gridDim.x * 4) {
    const size_t t = (size_t)(ti >> 12) * L + 128 + (ti & 4095);
    unsigned xb[16];
#pragma unroll
    for (int i = 0; i < 4; ++i) { const u32x4 q = *(const u32x4*)(h1 + t * 1024 + 32 * c + 8 * i); xb[4 * i] = q[0]; xb[4 * i + 1] = q[1]; xb[4 * i + 2] = q[2]; xb[4 * i + 3] = q[3]; }
    f32x2 yp[16];
#pragma unroll
    for (int i = 0; i < 16; ++i) yp[i] = f32x2{0.f, 0.f};
    f32x2 xp[16];
#pragma unroll
    for (int i = 0; i < 16; ++i) xp[i] = f32x2{bflo(xb[i]), bfhi(xb[i])};
#pragma unroll 1
    for (int bt = 0; bt < 4; ++bt) {
      const int emine = experts[t * 128 + 32 * bt + kofs]; const float gmine = gates[t * 128 + 32 * bt + kofs];
      const float su = tsc[emine], sv = tsc[16384 + emine];
      float pd[16];
      u32x4 Rv[16];
      {
        u32x4 Ru[16];
#pragma unroll
        for (int j = 0; j < 16; ++j) {
          const int e0 = __builtin_amdgcn_readlane(emine, 2 * j), e1 = __builtin_amdgcn_readlane(emine, 32 + 2 * j);
          Ru[j] = *(const u32x4*)(uq + (size_t)(hi ? e1 : e0) * 512 + 16 * c);
        }
#pragma unroll
        for (int j = 0; j < 16; ++j) {
          const int e0 = __builtin_amdgcn_readlane(emine, 2 * j), e1 = __builtin_amdgcn_readlane(emine, 32 + 2 * j);
          Rv[j] = *(const u32x4*)(vq + (size_t)(hi ? e1 : e0) * 512 + 16 * c);
        }
        __builtin_amdgcn_sched_barrier(0);
#pragma unroll
        for (int j = 0; j < 16; ++j) {
          f32x2 a2 = {0.f, 0.f}, a3 = {0.f, 0.f};
#pragma unroll
          for (int d = 0; d < 4; ++d) {
            a2 = __builtin_elementwise_fma(__builtin_amdgcn_cvt_scalef32_pk_f32_fp4(Ru[j][d], 1.0f, 0), xp[4 * d], a2);
            a3 = __builtin_elementwise_fma(__builtin_amdgcn_cvt_scalef32_pk_f32_fp4(Ru[j][d], 1.0f, 1), xp[4 * d + 1], a3);
            a2 = __builtin_elementwise_fma(__builtin_amdgcn_cvt_scalef32_pk_f32_fp4(Ru[j][d], 1.0f, 2), xp[4 * d + 2], a2);
            a3 = __builtin_elementwise_fma(__builtin_amdgcn_cvt_scalef32_pk_f32_fp4(Ru[j][d], 1.0f, 3), xp[4 * d + 3], a3);
          }
          pd[j] = (a2[0] + a2[1]) + (a3[0] + a3[1]);
        }
      }
#pragma unroll
      for (int i = 0; i < 8; ++i) { const float snd = b4 ? pd[i] : pd[i + 8], kp = b4 ? pd[i + 8] : pd[i]; pd[i] = kp + __shfl_xor(snd, 16); }
#pragma unroll
      for (int i = 0; i < 4; ++i) { const float snd = b3 ? pd[i] : pd[i + 4], kp = b3 ? pd[i + 4] : pd[i]; pd[i] = kp + __shfl_xor(snd, 8); }
#pragma unroll
      for (int i = 0; i < 2; ++i) { const float snd = b2 ? pd[i] : pd[i + 2], kp = b2 ? pd[i + 2] : pd[i]; pd[i] = kp + __shfl_xor(snd, 4); }
      { const float snd = b1 ? pd[0] : pd[1], kp = b1 ? pd[1] : pd[0]; pd[0] = kp + __shfl_xor(snd, 2); }
      const float dv = (pd[0] + __shfl_xor(pd[0], 1)) * su;
      const float act = 0.5f * dv * (1.f + erff(dv * 0.7071067811865476f));
      const float wg = gmine * act * sv;
      {
#pragma unroll
        for (int j = 0; j < 16; ++j) {
          const float w0 = __uint_as_float(__builtin_amdgcn_readlane(__float_as_uint(wg), 2 * j)), w1 = __uint_as_float(__builtin_amdgcn_readlane(__float_as_uint(wg), 32 + 2 * j));
          const float ws = hi ? w1 : w0; const f32x2 ws2 = {ws, ws};
#pragma unroll
          for (int d = 0; d < 4; ++d) {
            yp[4 * d] = __builtin_elementwise_fma(__builtin_amdgcn_cvt_scalef32_pk_f32_fp4(Rv[j][d], 1.0f, 0), ws2, yp[4 * d]);
            yp[4 * d + 1] = __builtin_elementwise_fma(__builtin_amdgcn_cvt_scalef32_pk_f32_fp4(Rv[j][d], 1.0f, 1), ws2, yp[4 * d + 1]);
            yp[4 * d + 2] = __builtin_elementwise_fma(__builtin_amdgcn_cvt_scalef32_pk_f32_fp4(Rv[j][d], 1.0f, 2), ws2, yp[4 * d + 2]);
            yp[4 * d + 3] = __builtin_elementwise_fma(__builtin_amdgcn_cvt_scalef32_pk_f32_fp4(Rv[j][d], 1.0f, 3), ws2, yp[4 * d + 3]);
          }
        }
      }
    }
    float z[16];
#pragma unroll
    for (int i = 0; i < 16; ++i) {
      const float ylo = yp[i >> 1][i & 1], yup = yp[8 + (i >> 1)][i & 1];
      const float lo = ylo + __shfl_xor(ylo, 32), up = yup + __shfl_xor(yup, 32);
      const unsigned xw = hi ? xb[8 + (i >> 1)] : xb[i >> 1];
      const float xv = (i & 1) ? bfhi(xw) : bflo(xw);
      z[i] = DN_ALPHA * xv + (hi ? up : lo);
    }
    float sm = 0.f;
#pragma unroll
    for (int i = 0; i < 16; ++i) sm += z[i];
    const float mu = wsum(sm) * (1.f / 1024.f);
    float q = 0.f;
#pragma unroll
    for (int i = 0; i < 16; ++i) { const float d = z[i] - mu; q += d * d; }
    const float rs = rsqrtf(wsum(q) * (1.f / 1024.f) + LN_EPS);
    const int e0 = 32 * c + (hi ? 16 : 0);
    float* od = p.out + (size_t)ti * 1024 + e0;
    const f32x4* g4 = (const f32x4*)(p.ln2g + e0); const f32x4* bb4 = (const f32x4*)(p.ln2b + e0);
#pragma unroll
    for (int k = 0; k < 4; ++k) {
      const f32x4 g = g4[k], bb = bb4[k]; f32x4 o;
#pragma unroll
      for (int i = 0; i < 4; ++i) o[i] = (z[4 * k + i] - mu) * rs * g[i] + bb[i];
      *(f32x4*)(od + 4 * k) = o;
    }
  }
}

#define XB_TMO      128
#define XB_XCNT(j)  (256  + 64 * (j))
#define XB_XSUB(j)  (1280 + 64 * (j))
#define XB_XGEN(j)  (2304 + 64 * (j))
#define XB_TOP      3328
#define XB_TOPGEN   3392
#define XB_SPIN_CAP (1u << 22)
#define LAS __attribute__((address_space(3)))
DEV unsigned xb_ld(unsigned* p) { return __hip_atomic_load(p, __ATOMIC_RELAXED, __HIP_MEMORY_SCOPE_AGENT); }
DEV unsigned xb_add(unsigned* p, unsigned v) { return __hip_atomic_fetch_add(p, v, __ATOMIC_RELAXED, __HIP_MEMORY_SCOPE_AGENT); }
DEV unsigned xb_xcc_id() { return (unsigned)__builtin_amdgcn_s_getreg((3 << 11) | 20) & 0xFu; }
#define XB_SPIN(cond, bar) do { unsigned _sp = 0; while (cond) { __builtin_amdgcn_s_sleep(1); \
    if ((++_sp & 255u) == 0u) { if (xb_ld(&(bar)[XB_TMO])) break; if (_sp > XB_SPIN_CAP) { atomicAdd(&(bar)[XB_TMO], 1u); break; } } } } while (0)
struct XcdBarrier { unsigned* bar; unsigned x; volatile LAS unsigned* st; };
DEV XcdBarrier xcd_barrier_post(unsigned* bar, volatile LAS unsigned* st) {
  XcdBarrier b; b.bar = bar; b.x = xb_xcc_id(); b.st = st;
  if (threadIdx.x == 0) (void)xb_add(&bar[XB_XCNT(b.x)], 1u);
  return b;
}
DEV void xcd_barrier_complete(unsigned* bar, unsigned x, unsigned& nloc, unsigned& nx) {
  const unsigned G = gridDim.x;
  unsigned sum, cnt, mine, sp = 0u;
  for (;;) {
    sum = 0u; cnt = 0u; mine = 0u;
#pragma unroll
    for (unsigned j = 0; j < 16; ++j) { const unsigned c = xb_ld(&bar[XB_XCNT(j)]); sum += c; cnt += (c > 0u) ? 1u : 0u; mine = (j == x) ? c : mine; }
    if (sum == G) break;
    __builtin_amdgcn_s_sleep(1);
    if ((++sp & 255u) == 0u) { if (xb_ld(&bar[XB_TMO])) break; if (sp > XB_SPIN_CAP) { atomicAdd(&bar[XB_TMO], 1u); break; } }
  }
  nloc = mine > 0u ? mine : 1u; nx = cnt > 0u ? cnt : 1u;
}
DEV void xcd_barrier(const XcdBarrier& b) {
  asm volatile("s_waitcnt vmcnt(0)" ::: "memory");
  __syncthreads();
  if (threadIdx.x == 0) {
    unsigned* bar = b.bar;
    __builtin_amdgcn_s_waitcnt(0);
    unsigned nloc = b.st[0], nx = b.st[1];
    if (nloc == 0u) { xcd_barrier_complete(bar, b.x, nloc, nx); b.st[0] = nloc; b.st[1] = nx; }
    const unsigned old = xb_add(&bar[XB_XSUB(b.x)], 1u);
    const unsigned gen = old / nloc;
    if (old + 1u == (gen + 1u) * nloc) {
      __builtin_amdgcn_fence(__ATOMIC_RELEASE, "agent");
      asm volatile("s_waitcnt vmcnt(0)" ::: "memory");
      const unsigned og = xb_add(&bar[XB_TOP], 1u);
      const unsigned tg = og / nx;
      if (og + 1u == (tg + 1u) * nx) xb_add(&bar[XB_TOPGEN], 1u);
      else XB_SPIN(xb_ld(&bar[XB_TOPGEN]) == tg, bar);
      __builtin_amdgcn_fence(__ATOMIC_ACQUIRE, "agent");
      xb_add(&bar[XB_XGEN(b.x)], 1u);
      asm volatile("s_waitcnt vmcnt(0)" ::: "memory");
    } else {
      XB_SPIN(xb_ld(&bar[XB_XGEN(b.x)]) == gen, bar);
      __builtin_amdgcn_fence(__ATOMIC_ACQUIRE, "agent");
      asm volatile("s_waitcnt vmcnt(0)" ::: "memory");
    }
  }
  __syncthreads();
}
DEV void grid_barrier(unsigned* ctr, unsigned target) {
  asm volatile("s_waitcnt vmcnt(0)" ::: "memory");
  __syncthreads();
  if (TIDX() == 0) {
    __builtin_amdgcn_fence(__ATOMIC_RELEASE, "agent");
    asm volatile("s_waitcnt vmcnt(0)" ::: "memory");
    __hip_atomic_fetch_add(ctr, 1u, __ATOMIC_RELAXED, __HIP_MEMORY_SCOPE_AGENT);
    while (__hip_atomic_load(ctr, __ATOMIC_RELAXED, __HIP_MEMORY_SCOPE_AGENT) < target) __builtin_amdgcn_s_sleep(2);
    __builtin_amdgcn_fence(__ATOMIC_ACQUIRE, "agent");
    asm volatile("s_waitcnt vmcnt(0)" ::: "memory");
  }
  __syncthreads();
}
constexpr int NPHASE = 10;
constexpr int LDS_BYTES = 55296 + 64;
template <int PH> DEV void run_phase(const Params& p0, char* lds) {
  Params p = p0;
  { size_t z = 0; asm volatile("" : "+s"(z) :: "memory"); p.ws = p0.ws + z; p.out = p0.out + z; }
  if constexpr (PH == 0) phase_prep(p, lds);
  if constexpr (PH == 1) phase_proj(p, lds);
  if constexpr (PH == 2) phase_g1(p, lds);
  if constexpr (PH == 3) phase_scan(p);
  if constexpr (PH == 4) phase_mix(p, lds);
  if constexpr (PH == 5) phase_outproj(p, lds);
  if constexpr (PH == 6) phase_ln1(p);
  if constexpr (PH == 7) phase_peerq(p, lds);
  if constexpr (PH == 8) phase_topk(p, lds);
  if constexpr (PH == 9) phase_experts(p);
}
#if MODE == 0
template <int PH> __global__ void __launch_bounds__(256, 2) phase_kernel(Params p) {
  __shared__ __attribute__((aligned(16))) char lds[LDS_BYTES];
  run_phase<PH>(p, lds);
}
#else
__global__ void __launch_bounds__(256, 2) mega(Params p) {
  __shared__ __attribute__((aligned(16))) char lds[LDS_BYTES];
  cg::grid_group grid = cg::this_grid();
#ifndef PHMASK
#define PHMASK 0x3ff
#endif
#ifndef DUP
#define DUP -1
#endif
#define RUNPH(i) if constexpr ((PHMASK >> i) & 1) { run_phase<i>(p, lds); if constexpr (i == DUP) { __syncthreads(); run_phase<i>(p, lds); } }
  __shared__ uint4 xb_words;
  if (threadIdx.x == 0) xb_words = make_uint4(0u, 0u, 0u, 0u);
  __syncthreads();
  XcdBarrier xb = xcd_barrier_post((unsigned*)(p.ws + OFF_BAR + 4096), (volatile LAS unsigned*)&xb_words);
  if (p.ws == nullptr) grid.sync();
  RUNPH(0); xcd_barrier(xb);
  RUNPH(1); xcd_barrier(xb);
  RUNPH(2); xcd_barrier(xb);
  RUNPH(3); xcd_barrier(xb);
  RUNPH(4); xcd_barrier(xb);
  RUNPH(5); xcd_barrier(xb);
  RUNPH(6); xcd_barrier(xb);
  RUNPH(7); xcd_barrier(xb);
  RUNPH(8); xcd_barrier(xb);
  RUNPH(9);
}
#endif

extern "C" void kernel_launch(void* const* d_in, const int* in_sizes, int n_in, void* d_out, int out_size, void* d_ws, size_t ws_size,
                              hipStream_t stream) {
  Params p{};
  p.x = (const float*)d_in[0]; p.meta = (const float*)d_in[1]; p.eg = (const float*)d_in[2]; p.eb = (const float*)d_in[3];
  p.w_in = (const float*)d_in[4]; p.w_gu = (const float*)d_in[5]; p.b_gate = (const float*)d_in[6]; p.b_forget = (const float*)d_in[7];
  p.gng = (const float*)d_in[8]; p.fng = (const float*)d_in[9]; p.w_out = (const float*)d_in[10]; p.ln1g = (const float*)d_in[11];
  p.ln1b = (const float*)d_in[12]; p.wq = (const float*)d_in[13]; p.subk = (const float*)d_in[14]; p.pu = (const float*)d_in[15];
  p.pv = (const float*)d_in[16]; p.ln2g = (const float*)d_in[17]; p.ln2b = (const float*)d_in[18];
  p.out = (float*)d_out; p.ws = (char*)d_ws;
  if (ws_size < WS_END) { fprintf(stderr, "workspace too small\n"); return; }
#if MODE == 0
  phase_kernel<0><<<dim3(1024), dim3(256), 0, stream>>>(p);
  phase_kernel<1><<<dim3(1024), dim3(256), 0, stream>>>(p);
  phase_kernel<2><<<dim3(1024), dim3(256), 0, stream>>>(p);
  phase_kernel<3><<<dim3(1024), dim3(256), 0, stream>>>(p);
  phase_kernel<4><<<dim3(1024), dim3(256), 0, stream>>>(p);
  phase_kernel<5><<<dim3(1024), dim3(256), 0, stream>>>(p);
  phase_kernel<6><<<dim3(1024), dim3(256), 0, stream>>>(p);
  phase_kernel<7><<<dim3(1024), dim3(256), 0, stream>>>(p);
  phase_kernel<8><<<dim3(256), dim3(256), 0, stream>>>(p);
  phase_kernel<9><<<dim3(2048), dim3(256), 0, stream>>>(p);
#else
  static int grid_blocks = 0;
  if (!grid_blocks) {
    int dev = 0, cus = 0, per_cu = 0;
    hipGetDevice(&dev);
    hipDeviceGetAttribute(&cus, hipDeviceAttributeMultiprocessorCount, dev);
    hipOccupancyMaxActiveBlocksPerMultiprocessor(&per_cu, mega, 256, 0);
    if (per_cu > 2) per_cu = 2;
    grid_blocks = cus * per_cu;
  }
  hipMemsetAsync((char*)d_ws + OFF_BAR, 0, 4096 + 16384, stream);
  void* args[] = {&p};
  hipError_t e = hipLaunchCooperativeKernel((void*)mega, dim3(grid_blocks), dim3(256), args, 0, stream);
  if (e != hipSuccess) fprintf(stderr, "cooperative launch failed: %s (grid %d)\n", hipGetErrorString(e), grid_blocks);
#endif
}
```

```cpp
#include <hip/hip_runtime.h>
#include <hip/hip_cooperative_groups.h>
#include <stdint.h>
#include <stdio.h>
namespace cg = cooperative_groups;

#ifndef MODE
#define MODE 1
#endif

#define DEV __device__ __forceinline__
typedef unsigned short u16;
using bf16x8 = __attribute__((ext_vector_type(8))) short;
using f32x16 = __attribute__((ext_vector_type(16))) float;
using u32x4 = __attribute__((ext_vector_type(4))) unsigned;
using u32x2 = __attribute__((ext_vector_type(2))) unsigned;
using f32x4 = __attribute__((ext_vector_type(4))) float;
using f32x2 = __attribute__((ext_vector_type(2))) float;

constexpr int DM = 1024, NB = 8, SEQ = 4096, L = 4224, T = NB * L, NPAD = 112;
constexpr int NCH = 66;
constexpr int NPROJ = 3200;
constexpr float LN_EPS = 1e-5f;
constexpr float DN_ALPHA = 1.189207115002721f;
constexpr float LOG2E = 1.4426950408889634f;
constexpr float C2 = 0.125f * LOG2E;

constexpr size_t OFF_WINT = 0;
constexpr size_t OFF_WOUTT = OFF_WINT + (size_t)NPROJ * 1024 * 2;
constexpr size_t OFF_WQT = OFF_WOUTT + (size_t)1024 * 1024 * 2;
constexpr size_t OFF_KEYS = OFF_WQT + (size_t)2048 * 1024 * 2;
constexpr size_t OFF_H0 = OFF_KEYS + (size_t)16 * 128 * 128 * 2;
constexpr size_t OFF_A = OFF_H0 + (size_t)T * 1024 * 2;
constexpr size_t A_GQ = OFF_A;
constexpr size_t A_GK = A_GQ + (size_t)NB * 4 * L * 64 * 2;
constexpr size_t A_GVT = A_GK + (size_t)NB * 4 * L * 64 * 2;
constexpr size_t A_GR = A_GVT + (size_t)NB * 4 * 128 * L * 2;
constexpr size_t A_FQ = A_GR + (size_t)T * 512 * 2;
constexpr size_t A_FK = A_FQ + (size_t)NB * 8 * L * 64 * 2;
constexpr size_t A_FVT = A_FK + (size_t)NB * 8 * L * 64 * 2;
constexpr size_t A_QAUG = A_FVT + (size_t)NB * 8 * 64 * L * 2;
constexpr size_t A_KAUG = A_QAUG + (size_t)NB * 8 * L * 16 * 2;
constexpr size_t A_GA = A_KAUG + (size_t)NB * 8 * L * 16 * 2;
constexpr size_t A_LOGF = A_GA + (size_t)T * 16 * 4;
constexpr size_t A_DEC = A_LOGF + (size_t)T * 8 * 4;
constexpr size_t A_C2 = A_DEC + (size_t)NB * 4 * NCH * 64 * 4;
constexpr size_t A_END = A_C2 + (size_t)64 * L * 4;
constexpr size_t OFF_ST = (A_END + 255) & ~(size_t)255;
constexpr size_t OFF_O = OFF_ST + (size_t)T * 1024 * 2;
constexpr size_t OFF_BAR = OFF_O + (size_t)T * 1024 * 2;
constexpr size_t OFF_TBL = OFF_BAR + 4096 + 16384;
constexpr size_t WS_END = OFF_TBL + (size_t)2 * 16384 * 768 + (size_t)2 * 16384 * 4;
constexpr int BAR_QN = 64, BAR_KN = 128, BAR_WQ = 256;
static_assert(WS_END <= (size_t)512 * 1024 * 1024, "workspace");
static_assert((size_t)NB * 4 * NCH * 128 * 64 * 4 == (size_t)T * 1024 * 2, "state size");

struct Params {
  const float *x, *meta, *eg, *eb, *w_in, *w_gu, *b_gate, *b_forget, *gng, *fng, *w_out, *ln1g, *ln1b, *wq, *subk, *pu, *pv, *ln2g, *ln2b;
  float* out; char* ws;
};

typedef unsigned v6u __attribute__((ext_vector_type(6)));
typedef float v16f __attribute__((ext_vector_type(16)));
typedef float v32f __attribute__((ext_vector_type(32)));
typedef __bf16 v32b __attribute__((ext_vector_type(32)));
typedef __bf16 v2b __attribute__((ext_vector_type(2)));
typedef unsigned v16u __attribute__((ext_vector_type(16)));
constexpr size_t TBL_U = 0, TBL_V = (size_t)16384 * 512, TBL_SC = (size_t)2 * 16384 * 512;
DEV int TIDX() { int t = (int)threadIdx.x; asm volatile("" : "+v"(t)); return t; }
typedef __bf16 bf16x2_t __attribute__((ext_vector_type(2)));
DEV unsigned cvtpk(float lo, float hi) { bf16x2_t v = {(__bf16)lo, (__bf16)hi}; return __builtin_bit_cast(unsigned, v); }
DEV u16 f2bf(float f) { return (u16)(cvtpk(f, 0.f) & 0xffffu); }
DEV float bf2f(u16 b) { return __uint_as_float(((unsigned)b) << 16); }
DEV float bflo(unsigned u) { return __uint_as_float(u << 16); }
DEV float bfhi(unsigned u) { return __uint_as_float(u & 0xffff0000u); }
DEV int crow(int r, int hh) { return (r & 3) + 8 * (r >> 2) + 4 * hh; }
DEV float wsum(float v) {
#pragma unroll
  for (int o = 32; o > 0; o >>= 1) v += __shfl_xor(v, o);
  return v;
}
DEV float logsig(float z) { return fminf(z, 0.f) - log1pf(expf(-fabsf(z))); }
#define MFMA(a, b, c) __builtin_amdgcn_mfma_f32_32x32x16_bf16(a, b, c, 0, 0, 0)
DEV bf16x8 asbf(u32x4 v) { return __builtin_bit_cast(bf16x8, v); }

DEV int winmap(int n) {
  if (n < 1536) return n;
  if (n < 3072) return n + 16;
  if (n < 3088) return 1536 + (n - 3072);
  if (n < 3096) return n;
  return -1;
}
template <bool MAP>
DEV void transpose_tile(const float* __restrict__ src, int ldsrc, u16* __restrict__ dst, int k0, int n0, char* lds) {
  float* tl = (float*)lds;
  const int tx = TIDX() & 63, ty = TIDX() >> 6;
  const int n = n0 + tx; const int on = MAP ? winmap(n) : n;
#pragma unroll
  for (int i = 0; i < 16; ++i) { const int k = ty + 4 * i; tl[k * 65 + tx] = (on >= 0) ? src[(size_t)(k0 + k) * ldsrc + on] : 0.f; }
  __syncthreads();
#pragma unroll
  for (int i = 0; i < 16; ++i) { const int nn = ty + 4 * i; dst[(size_t)(n0 + nn) * 1024 + k0 + tx] = f2bf(tl[tx * 65 + nn]); }
  __syncthreads();
}
DEV void ln_row_to_bf16(const float* src, const float* g, const float* bb, u16* dst, int lane) {
  float v[16];
  if (src) {
    const f32x4* s4 = (const f32x4*)src;
    f32x4 a0 = s4[2 * lane], a1 = s4[2 * lane + 1], b0 = s4[128 + 2 * lane], b1 = s4[128 + 2 * lane + 1];
#pragma unroll
    for (int i = 0; i < 4; ++i) { v[i] = a0[i]; v[4 + i] = a1[i]; v[8 + i] = b0[i]; v[12 + i] = b1[i]; }
  } else {
#pragma unroll
    for (int i = 0; i < 16; ++i) v[i] = 0.f;
  }
  float s = 0.f;
#pragma unroll
  for (int i = 0; i < 16; ++i) s += v[i];
  const float mu = wsum(s) * (1.f / 1024.f);
  float q = 0.f;
#pragma unroll
  for (int i = 0; i < 16; ++i) { const float d = v[i] - mu; q += d * d; }
  const float rs = rsqrtf(wsum(q) * (1.f / 1024.f) + LN_EPS);
  unsigned pk[8];
#pragma unroll
  for (int i = 0; i < 8; ++i) {
    const int e0 = (i < 4) ? (8 * lane + 2 * i) : (512 + 8 * lane + 2 * (i - 4));
    const float y0 = (v[2 * i] - mu) * rs * g[e0] + bb[e0];
    const float y1 = (v[2 * i + 1] - mu) * rs * g[e0 + 1] + bb[e0 + 1];
    pk[i] = cvtpk(y0, y1);
  }
  *(u32x4*)(dst + 8 * lane) = u32x4{pk[0], pk[1], pk[2], pk[3]};
  *(u32x4*)(dst + 512 + 8 * lane) = u32x4{pk[4], pk[5], pk[6], pk[7]};
}
DEV void phase_prep(const Params& p, char* lds) {
  u16* winT = (u16*)(p.ws + OFF_WINT); u16* woutT = (u16*)(p.ws + OFF_WOUTT); u16* wqT = (u16*)(p.ws + OFF_WQT);
  u16* keys = (u16*)(p.ws + OFF_KEYS); u16* h0 = (u16*)(p.ws + OFF_H0);
  const int n_win = 50 * 16, n_wout = 16 * 16, n_wq = 32 * 16, n_keys = 128, n_ln = T / 4;
  const int total = n_win + n_wout + n_wq + n_keys + n_ln;
  for (int it = blockIdx.x; it < total; it += gridDim.x) {
    int i = it;
    if (i < n_win) { transpose_tile<true>(p.w_in, 3096, winT, (i & 15) * 64, (i >> 4) * 64, lds); continue; }
    i -= n_win;
    if (i < n_wout) { transpose_tile<false>(p.w_out, 1024, woutT, (i & 15) * 64, (i >> 4) * 64, lds); continue; }
    i -= n_wout;
    if (i < n_wq) { transpose_tile<false>(p.wq, 2048, wqT, (i & 15) * 64, (i >> 4) * 64, lds); continue; }
    i -= n_wq;
    if (i < n_keys) {
      const size_t e = ((size_t)i * 256 + TIDX()) * 8;
      const f32x4 a = *(const f32x4*)(p.subk + e), b = *(const f32x4*)(p.subk + e + 4);
      *(u32x4*)(keys + e) = u32x4{cvtpk(a[0], a[1]), cvtpk(a[2], a[3]), cvtpk(b[0], b[1]), cvtpk(b[2], b[3])};
      continue;
    }
    i -= n_keys;
    {
      const int t = i * 4 + __builtin_amdgcn_readfirstlane(TIDX() >> 6); const int b = t / L, l = t % L;
      const float* src = (l < NPAD) ? nullptr : (l < 128 ? p.meta + (size_t)(l - NPAD) * 1024 : p.x + ((size_t)b * SEQ + (l - 128)) * 1024);
      ln_row_to_bf16(src, p.eg, p.eb, h0 + (size_t)t * 1024, TIDX() & 63);
    }
  }
}

template <int V> struct IC { static constexpr int value = V; };
template <int I, int N, class F> DEV void static_for(F&& f) { if constexpr (I < N) { f(IC<I>{}); static_for<I + 1, N>(f); } }
template <int MI>
DEV void gemm_core(const u16* __restrict__ A, int lda, const u16* __restrict__ Bt, int ldb, int K, int m0, int n0, char* lds, f32x16 (&acc)[MI][2]) {
  const int tid = TIDX(), lane = tid & 63, w = __builtin_amdgcn_readfirstlane(tid >> 6), r32 = lane & 31, hh = lane >> 5;
  const int wm = w >> 1, wn = w & 1;
  u16* As = (u16*)lds; u16* Bs = As + 64 * MI * 72;
#pragma unroll
  for (int i = 0; i < MI; ++i)
#pragma unroll
    for (int j = 0; j < 2; ++j)
#pragma unroll
      for (int r = 0; r < 16; ++r) acc[i][j][r] = 0.f;
  const int lrow = tid >> 3, lch = tid & 7;
  const u16* Ap = A + (size_t)(m0 + lrow) * lda + lch * 8;
  const u16* Bp = Bt + (size_t)(n0 + lrow) * ldb + lch * 8;
  u32x4 ra[2 * MI], rb[4];
#pragma unroll
  for (int i = 0; i < 2 * MI; ++i) ra[i] = *(const u32x4*)(Ap + (size_t)(32 * i) * lda);
#pragma unroll
  for (int i = 0; i < 4; ++i) rb[i] = *(const u32x4*)(Bp + (size_t)(32 * i) * ldb);
  const int nk = K / 64;
  for (int kt = 0; kt < nk; ++kt) {
    __syncthreads();
#pragma unroll
    for (int i = 0; i < 2 * MI; ++i) *(u32x4*)(As + (lrow + 32 * i) * 72 + lch * 8) = ra[i];
#pragma unroll
    for (int i = 0; i < 4; ++i) *(u32x4*)(Bs + (lrow + 32 * i) * 72 + lch * 8) = rb[i];
    __syncthreads();
    if (kt + 1 < nk) {
      const int k0 = (kt + 1) * 64;
#pragma unroll
      for (int i = 0; i < 2 * MI; ++i) ra[i] = *(const u32x4*)(Ap + (size_t)(32 * i) * lda + k0);
#pragma unroll
      for (int i = 0; i < 4; ++i) rb[i] = *(const u32x4*)(Bp + (size_t)(32 * i) * ldb + k0);
    }
#pragma unroll
    for (int ks = 0; ks < 4; ++ks) {
      bf16x8 a[MI], b[2];
#pragma unroll
      for (int i = 0; i < MI; ++i) a[i] = *(const bf16x8*)(As + (wm * 32 * MI + i * 32 + r32) * 72 + ks * 16 + hh * 8);
#pragma unroll
      for (int i = 0; i < 2; ++i) b[i] = *(const bf16x8*)(Bs + (wn * 64 + i * 32 + r32) * 72 + ks * 16 + hh * 8);
#pragma unroll
      for (int i = 0; i < MI; ++i)
#pragma unroll
        for (int j = 0; j < 2; ++j) acc[i][j] = MFMA(a[i], b[j], acc[i][j]);
    }
  }
}
template <int MI, class Epi>
DEV void gemm_direct_epi(f32x16 (&acc)[MI][2], int m0, int n0, Epi epi) {
  const int tid = TIDX(), lane = tid & 63, w = __builtin_amdgcn_readfirstlane(tid >> 6), r32 = lane & 31, hh = lane >> 5;
  const int wm = w >> 1, wn = w & 1;
  static_for<0, MI * 8>([&](auto idx) __attribute__((always_inline)) {
    constexpr int e = decltype(idx)::value; constexpr int i = e >> 3, j = (e >> 2) & 1, g = e & 3;
    const int row = m0 + wm * 32 * MI + i * 32 + 8 * g + 4 * hh;
    const int col = n0 + wn * 64 + j * 32 + r32;
    epi(row, col, acc[i][j][4 * g], acc[i][j][4 * g + 1], acc[i][j][4 * g + 2], acc[i][j][4 * g + 3]);
  });
}
template <int MI, class Epi>
DEV void gemm_tile(const u16* __restrict__ A, int lda, const u16* __restrict__ Bt, int ldb, int K, int m0, int n0, char* lds, Epi epi) {
  f32x16 acc[MI][2];
  gemm_core<MI>(A, lda, Bt, ldb, K, m0, n0, lds, acc);
  gemm_direct_epi<MI>(acc, m0, n0, epi);
}
DEV void gemm_stagedT_epi(f32x16 (&acc)[4][2], int m0, int c0, char* lds, u16* __restrict__ dst) {
  const int tid = TIDX(), lane = tid & 63, w = __builtin_amdgcn_readfirstlane(tid >> 6), r32 = lane & 31, hh = lane >> 5;
  const int wm = w >> 1, wn = w & 1;
  u16* Cs = (u16*)lds;
#pragma unroll 1
  for (int half = 0; half < 2; ++half) {
    __syncthreads();
    if (wn == half) {
      static_for<0, 32>([&](auto idx) __attribute__((always_inline)) {
        constexpr int e = decltype(idx)::value; constexpr int i = e >> 3, j = (e >> 2) & 1, g = e & 3;
        const int rl = wm * 128 + i * 32 + 8 * g + 4 * hh, cl = j * 32 + r32;
        *(u32x2*)(Cs + cl * 264 + rl) = u32x2{cvtpk(acc[i][j][4 * g], acc[i][j][4 * g + 1]), cvtpk(acc[i][j][4 * g + 2], acc[i][j][4 * g + 3])};
      });
    }
    __syncthreads();
#pragma unroll
    for (int q = 0; q < 8; ++q) {
      const int id = tid + 256 * q; const int cl = id >> 5, ch = id & 31;
      const int row = m0 + 8 * ch; const int b = row / L, l = row % L;
      *(u32x4*)(dst + ((size_t)(b * 512 + c0 + half * 64 + cl)) * L + l) = *(const u32x4*)(Cs + cl * 264 + 8 * ch);
    }
  }
}

DEV void phase_proj(const Params& p, char* lds) {
  const u16* h0 = (const u16*)(p.ws + OFF_H0); const u16* winT = (const u16*)(p.ws + OFF_WINT);
  u16* gq = (u16*)(p.ws + A_GQ); u16* gk = (u16*)(p.ws + A_GK); u16* gvT = (u16*)(p.ws + A_GVT); u16* gr = (u16*)(p.ws + A_GR);
  u16* fq = (u16*)(p.ws + A_FQ); u16* fk = (u16*)(p.ws + A_FK); u16* fvT = (u16*)(p.ws + A_FVT);
  float* ga = (float*)(p.ws + A_GA); float* logf = (float*)(p.ws + A_LOGF);
  const float* bfg = p.b_forget;
  const bool xa = (gridDim.x & 7) == 0;
  const int xg = blockIdx.x & 7, xq = blockIdx.x >> 3, xn = gridDim.x >> 3;
  const int ntiles = xa ? (132 * 3 + 17) : 132 * 25;
  auto epi = [&](int row, int col, float v0, float v1, float v2, float v3) __attribute__((always_inline)) {
      const int b = row / L, l = row % L;
      const float v[4] = {v0, v1, v2, v3};
      if (col < 256) {
        const int hd = col >> 6, d = col & 63; u16* dst = gq + ((size_t)(b * 4 + hd) * L + l) * 64 + d;
#pragma unroll
        for (int i = 0; i < 4; ++i) dst[i * 64] = f2bf(v[i]);
      } else if (col < 512) {
        const int c = col - 256, hd = c >> 6, d = c & 63; u16* dst = gk + ((size_t)(b * 4 + hd) * L + l) * 64 + d;
#pragma unroll
        for (int i = 0; i < 4; ++i) dst[i * 64] = (l + i >= NPAD) ? f2bf(v[i]) : (u16)0;
      } else if (col < 1024) {
        const int c = col - 512, hd = c >> 7, vd = c & 127;
        *(u32x2*)(gvT + ((size_t)(b * 4 + hd) * 128 + vd) * L + l) = u32x2{cvtpk(v0, v1), cvtpk(v2, v3)};
      } else if (col < 1536) {
        const int c = col - 1024; u16* dst = gr + (size_t)row * 512 + c;
#pragma unroll
        for (int i = 0; i < 4; ++i) dst[i * 512] = f2bf(v[i]);
      } else if (col < 2048) {
        const int c = col - 1536, h = c >> 6, d = c & 63; u16* dst = fq + ((size_t)(b * 8 + h) * L + l) * 64 + d;
#pragma unroll
        for (int i = 0; i < 4; ++i) dst[i * 64] = f2bf(v[i] * C2);
      } else if (col < 2560) {
        const int c = col - 2048, h = c >> 6, d = c & 63; u16* dst = fk + ((size_t)(b * 8 + h) * L + l) * 64 + d;
#pragma unroll
        for (int i = 0; i < 4; ++i) dst[i * 64] = f2bf(v[i]);
      } else if (col < 3072) {
        const int c = col - 2560, h = c >> 6, d = c & 63;
        *(u32x2*)(fvT + ((size_t)(b * 8 + h) * 64 + d) * L + l) = u32x2{cvtpk(v0, v1), cvtpk(v2, v3)};
      } else {
        const int c = col - 3072;
        if (c < 16) {
#pragma unroll
          for (int i = 0; i < 4; ++i) ga[(size_t)(row + i) * 16 + c] = v[i];
        } else if (c < 24) {
          const float bf_ = bfg[c - 16];
#pragma unroll
          for (int i = 0; i < 4; ++i) logf[(size_t)(row + i) * 8 + (c - 16)] = logsig(v[i] + bf_);
        }
      }
    };
  const int nfull = xa ? (ntiles / xn) * xn : ntiles, nunits = xa ? nfull + 2 * (ntiles - nfull) : ntiles;
  for (int j = xa ? xq : (int)blockIdx.x; j < nunits; j += xa ? xn : (int)gridDim.x) {
    const int t = (j < nfull) ? j : nfull + ((j - nfull) >> 1); const int half = (j < nfull) ? -1 : ((j - nfull) & 1);
    int mt, nt;
    if (!xa) { mt = t / 25; nt = t % 25; }
    else if (t < 396) { mt = t / 3; nt = xg + 8 * (t % 3); }
    else { mt = xg + 8 * (t - 396); nt = 24; if (mt >= 132) continue; }
    if (half >= 0) {
      f32x16 acc2[2][2];
      gemm_core<2>(h0, 1024, winT, 1024, 1024, mt * 256 + half * 128, nt * 128, lds, acc2);
      gemm_direct_epi<2>(acc2, mt * 256 + half * 128, nt * 128, epi);
      continue;
    }
    f32x16 acc[4][2];
    gemm_core<4>(h0, 1024, winT, 1024, 1024, mt * 256, nt * 128, lds, acc);
    if ((nt >> 2) == 1) { gemm_stagedT_epi(acc, mt * 256, (nt - 4) * 128, lds, gvT); continue; }
    if ((nt >> 2) == 5) { gemm_stagedT_epi(acc, mt * 256, (nt - 20) * 128, lds, fvT); continue; }
    gemm_direct_epi<4>(acc, mt * 256, nt * 128, epi);
  }
}

DEV float logsig_fast(float z) { return fminf(z, 0.f) - __logf(1.f + __expf(-fabsf(z))); }
DEV void gla_gates(const Params& p, int b, int hd, int n, float* G) {
  const float* ga = (const float*)(p.ws + A_GA);
  const int tid = TIDX(), d = tid & 63, qd = __builtin_amdgcn_readfirstlane(tid >> 6);
  const int cc = hd * 64 + d;
  float wv[16];
#pragma unroll
  for (int r = 0; r < 16; ++r) wv[r] = p.w_gu[r * 256 + cc];
  const float bg = p.b_gate[cc];
  const float* gap = ga + ((size_t)b * L + 64 * n + 16 * qd) * 16;
  float v[16]; float run = 0.f;
#pragma unroll
  for (int i = 0; i < 16; ++i) {
    float z = bg;
#pragma unroll
    for (int r = 0; r < 16; ++r) z = fmaf(gap[i * 16 + r], wv[r], z);
    run += logsig_fast(z) * (1.f / 16.f); v[i] = run;
  }
  float* tot = G + 64 * 65;
  tot[qd * 64 + d] = run;
  __syncthreads();
  float off = 0.f;
  for (int k = 0; k < qd; ++k) off += tot[k * 64 + d];
#pragma unroll
  for (int i = 0; i < 16; ++i) G[(16 * qd + i) * 65 + d] = v[i] + off;
  __syncthreads();
}

DEV void gla_g1_item(const Params& p, int b, int hd, int n, char* lds) {
  float* G = (float*)lds;
  u16* KT = (u16*)(lds + 16640);
  const u16* gk = (const u16*)(p.ws + A_GK); const u16* gvT = (const u16*)(p.ws + A_GVT);
  float* st = (float*)(p.ws + OFF_ST); float* dec = (float*)(p.ws + A_DEC);
  const int tid = TIDX(), lane = tid & 63, w = __builtin_amdgcn_readfirstlane(tid >> 6), r32 = lane & 31, hh = lane >> 5;
  const int bh = b * 4 + hd;
  gla_gates(p, b, hd, n, G);
  {
    const int c = tid >> 2, dq = tid & 3;
    const u16* kr = gk + ((size_t)bh * L + 64 * n + c) * 64 + 16 * dq;
    const u32x4 k0 = *(const u32x4*)kr, k1 = *(const u32x4*)(kr + 8);
    const unsigned kk[8] = {k0[0], k0[1], k0[2], k0[3], k1[0], k1[1], k1[2], k1[3]};
#pragma unroll
    for (int j = 0; j < 16; ++j) {
      const int d = 16 * dq + j;
      const float kv = (j & 1) ? bfhi(kk[j >> 1]) : bflo(kk[j >> 1]);
      KT[d * 72 + c] = f2bf(kv * __expf(G[63 * 65 + d] - G[c * 65 + d]));
    }
    if (tid < 64) dec[((size_t)bh * NCH + n) * 64 + tid] = __expf(G[63 * 65 + tid]);
  }
  __syncthreads();
  f32x16 acc[2];
#pragma unroll
  for (int r = 0; r < 16; ++r) { acc[0][r] = 0.f; acc[1][r] = 0.f; }
  const u16* vrow = gvT + ((size_t)bh * 128 + 32 * w + r32) * L + 64 * n + 8 * hh;
#pragma unroll
  for (int ks = 0; ks < 4; ++ks) {
    const bf16x8 a = *(const bf16x8*)(vrow + 16 * ks);
#pragma unroll
    for (int dt = 0; dt < 2; ++dt) {
      const bf16x8 bb = *(const bf16x8*)(KT + (32 * dt + r32) * 72 + 16 * ks + 8 * hh);
      acc[dt] = MFMA(a, bb, acc[dt]);
    }
  }
  float* so = st + ((size_t)bh * NCH + n) * 128 * 64;
#pragma unroll
  for (int dt = 0; dt < 2; ++dt)
#pragma unroll
    for (int r = 0; r < 16; ++r) so[(size_t)(32 * w + crow(r, hh)) * 64 + 32 * dt + r32] = acc[dt][r];
  __syncthreads();
}

DEV void split3(float x, u16& a, u16& b, u16& c) {
  a = f2bf(x); float r = x - bf2f(a); b = f2bf(r); r -= bf2f(b); c = f2bf(r);
}
DEV void fox_cscan(const Params& p, int bh) {
  const float* logf = (const float*)(p.ws + A_LOGF);
  u16* qaug = (u16*)(p.ws + A_QAUG); u16* kaug = (u16*)(p.ws + A_KAUG);
  const int lane = TIDX() & 63; const int b = bh >> 3, h = bh & 7;
  float carry = 0.f;
  float lv[L / 64];
#pragma unroll
  for (int i = 0; i < L / 64; ++i) lv[i] = logf[((size_t)b * L + 64 * i + lane) * 8 + h];
#pragma unroll
  for (int i = 0; i < L / 64; ++i) {
    const int l = 64 * i + lane;
    float v = lv[i];
#pragma unroll
    for (int o = 1; o < 64; o <<= 1) { const float u = __shfl_up(v, o); if (lane >= o) v += u; }
    const float c = (carry + v) * LOG2E;
    carry += __shfl(v, 63);
    ((float*)(p.ws + A_C2))[(size_t)bh * L + l] = c;
    u16 a0, a1, a2, n0, n1, n2;
    split3(c, a0, a1, a2); split3(-c, n0, n1, n2);
    const u16 one = 0x3f80;
    u16* qa = qaug + ((size_t)bh * L + l) * 16; u16* ka = kaug + ((size_t)bh * L + l) * 16;
    *(u32x4*)qa = u32x4{(unsigned)one | ((unsigned)one << 16), (unsigned)one | ((unsigned)a0 << 16), (unsigned)a1 | ((unsigned)a2 << 16), 0u};
    *(u32x4*)(qa + 8) = u32x4{0u, 0u, 0u, 0u};
    *(u32x4*)ka = u32x4{(unsigned)n0 | ((unsigned)n1 << 16), (unsigned)n2 | ((unsigned)one << 16), (unsigned)one | ((unsigned)one << 16), 0u};
    *(u32x4*)(ka + 8) = u32x4{0u, 0u, 0u, 0u};
  }
}
DEV void fox_norms(const Params& p, int wi) {
  const int bh = wi / NCH, l = (wi % NCH) * 64 + (TIDX() & 63);
  const u16* fq = (const u16*)(p.ws + A_FQ) + ((size_t)bh * L + l) * 64; const u16* fk = (const u16*)(p.ws + A_FK) + ((size_t)bh * L + l) * 64;
  float sq = 0.f, sk = 0.f;
#pragma unroll
  for (int i = 0; i < 8; ++i) {
    const u32x4 a = *(const u32x4*)(fq + 8 * i), b = *(const u32x4*)(fk + 8 * i);
#pragma unroll
    for (int j = 0; j < 4; ++j) { sq += bflo(a[j]) * bflo(a[j]) + bfhi(a[j]) * bfhi(a[j]); sk += bflo(b[j]) * bflo(b[j]) + bfhi(b[j]) * bfhi(b[j]); }
  }
#pragma unroll
  for (int o = 32; o > 0; o >>= 1) { sq = fmaxf(sq, __shfl_xor(sq, o)); sk = fmaxf(sk, __shfl_xor(sk, o)); }
  if ((TIDX() & 63) == 0) {
    unsigned* bar = (unsigned*)(p.ws + OFF_BAR);
    atomicMax(bar + BAR_QN + bh, __float_as_uint(sq)); atomicMax(bar + BAR_KN + bh, __float_as_uint(sk));
  }
}
DEV void phase_g1(const Params& p, char* lds) {
  const int n_g1 = NB * 4 * NCH, n_cs = 16, n_nm = 64 * NCH / 4;
  for (int it = blockIdx.x; it < n_g1 + n_cs + n_nm; it += gridDim.x) {
    if (it < n_cs) fox_cscan(p, it * 4 + __builtin_amdgcn_readfirstlane(TIDX() >> 6));
    else if (it < n_cs + n_nm) fox_norms(p, (it - n_cs) * 4 + __builtin_amdgcn_readfirstlane(TIDX() >> 6));
    else { const int i = it - n_cs - n_nm; const int bh = i / NCH, n = i % NCH; gla_g1_item(p, bh >> 2, bh & 3, n, lds); }
  }
}

DEV void quant_rows(const Params& p, int wi, int lane);
DEV void phase_scan(const Params& p) {
  float* st = (float*)(p.ws + OFF_ST); const float* dec = (const float*)(p.ws + A_DEC);
  const int n_sc = NB * 4 * 8192 / 512, n_qt = 16384 / 4;
  for (int it = blockIdx.x; it < n_sc + n_qt; it += gridDim.x) {
    if (it >= n_sc) { const int tid = TIDX(); quant_rows(p, (it - n_sc) * 4 + __builtin_amdgcn_readfirstlane(tid >> 6), tid & 63); continue; }
    const int e = it * 512 + TIDX(); const int bh = e >> 13, r = e & 8191, d = r & 63;
    float* sp = st + (size_t)bh * NCH * 8192 + r; const float* dp = dec + (size_t)bh * NCH * 64 + d;
    float S0 = 0.f, S1 = 0.f;
#pragma unroll 1
    for (int n0 = 0; n0 < NCH; n0 += 11) {
      float d0[11], d1[11], dc[11];
#pragma unroll
      for (int j = 0; j < 11; ++j) { d0[j] = sp[(size_t)(n0 + j) * 8192]; d1[j] = sp[(size_t)(n0 + j) * 8192 + 256]; dc[j] = dp[(n0 + j) * 64]; }
#pragma unroll
      for (int j = 0; j < 11; ++j) { const float o0 = S0, o1 = S1; S0 = dc[j] * S0 + d0[j]; S1 = dc[j] * S1 + d1[j]; d0[j] = o0; d1[j] = o1; }
#pragma unroll
      for (int j = 0; j < 11; ++j) { sp[(size_t)(n0 + j) * 8192] = d0[j]; sp[(size_t)(n0 + j) * 8192 + 256] = d1[j]; }
    }
  }
}

DEV void gla_g3_item(const Params& p, int b, int hd, int n, char* lds) {
  float* G = (float*)lds;
  u16* QI = (u16*)(lds + 16640); u16* KI = QI + 64 * 72; u16* QD = KI + 64 * 72;
  float* part = (float*)(lds + 16640 + 3 * 9216);
  const u16* gq = (const u16*)(p.ws + A_GQ); const u16* gk = (const u16*)(p.ws + A_GK); const u16* gvT = (const u16*)(p.ws + A_GVT);
  const u16* gr = (const u16*)(p.ws + A_GR); const float* st = (const float*)(p.ws + OFF_ST); u16* o = (u16*)(p.ws + OFF_O);
  const int tid = TIDX(), lane = tid & 63, w = __builtin_amdgcn_readfirstlane(tid >> 6), r32 = lane & 31, hh = lane >> 5;
  const int bh = b * 4 + hd;
  gla_gates(p, b, hd, n, G);
  {
    const int c = tid >> 2, dq = tid & 3;
    const size_t ro = ((size_t)bh * L + 64 * n + c) * 64 + 16 * dq;
    const u32x4 q0 = *(const u32x4*)(gq + ro), q1 = *(const u32x4*)(gq + ro + 8), k0 = *(const u32x4*)(gk + ro), k1 = *(const u32x4*)(gk + ro + 8);
    const unsigned qq[8] = {q0[0], q0[1], q0[2], q0[3], q1[0], q1[1], q1[2], q1[3]};
    const unsigned kk[8] = {k0[0], k0[1], k0[2], k0[3], k1[0], k1[1], k1[2], k1[3]};
    unsigned oqi[8], oki[8], oqd[8];
#pragma unroll
    for (int j2 = 0; j2 < 8; ++j2) {
      float qi[2], ki[2], qd[2];
#pragma unroll
      for (int e = 0; e < 2; ++e) {
        const int d = 16 * dq + 2 * j2 + e;
        const float qv = e ? bfhi(qq[j2]) : bflo(qq[j2]); const float kv = e ? bfhi(kk[j2]) : bflo(kk[j2]);
        const float bc = G[c * 65 + d], br = G[31 * 65 + d];
        qi[e] = qv * __expf(bc - br) * 0.125f; ki[e] = kv * __expf(br - bc); qd[e] = qv * __expf(bc) * 0.125f;
      }
      oqi[j2] = cvtpk(qi[0], qi[1]); oki[j2] = cvtpk(ki[0], ki[1]); oqd[j2] = cvtpk(qd[0], qd[1]);
    }
    *(u32x4*)(QI + c * 72 + 16 * dq) = u32x4{oqi[0], oqi[1], oqi[2], oqi[3]}; *(u32x4*)(QI + c * 72 + 16 * dq + 8) = u32x4{oqi[4], oqi[5], oqi[6], oqi[7]};
    *(u32x4*)(KI + c * 72 + 16 * dq) = u32x4{oki[0], oki[1], oki[2], oki[3]}; *(u32x4*)(KI + c * 72 + 16 * dq + 8) = u32x4{oki[4], oki[5], oki[6], oki[7]};
    *(u32x4*)(QD + c * 72 + 16 * dq) = u32x4{oqd[0], oqd[1], oqd[2], oqd[3]}; *(u32x4*)(QD + c * 72 + 16 * dq + 8) = u32x4{oqd[4], oqd[5], oqd[6], oqd[7]};
  }
  __syncthreads();
  f32x16 at[2][2];
#pragma unroll
  for (int i = 0; i < 2; ++i)
#pragma unroll
    for (int j = 0; j < 2; ++j)
#pragma unroll
      for (int r = 0; r < 16; ++r) at[i][j][r] = 0.f;
#pragma unroll
  for (int ks = 0; ks < 4; ++ks) {
    bf16x8 ka[2], qb[2];
#pragma unroll
    for (int i = 0; i < 2; ++i) { ka[i] = *(const bf16x8*)(KI + (32 * i + r32) * 72 + 16 * ks + 8 * hh); qb[i] = *(const bf16x8*)(QI + (32 * i + r32) * 72 + 16 * ks + 8 * hh); }
#pragma unroll
    for (int i = 0; i < 2; ++i)
#pragma unroll
      for (int j = 0; j < 2; ++j) at[i][j] = MFMA(ka[i], qb[j], at[i][j]);
  }
  unsigned pw[2][2][8];
#pragma unroll
  for (int stt = 0; stt < 2; ++stt)
#pragma unroll
    for (int ct = 0; ct < 2; ++ct)
#pragma unroll
      for (int r2 = 0; r2 < 8; ++r2) {
        const int s0 = 32 * stt + crow(2 * r2, hh), cc = 32 * ct + r32;
        const float v0 = (s0 <= cc) ? at[stt][ct][2 * r2] : 0.f, v1 = (s0 + 1 <= cc) ? at[stt][ct][2 * r2 + 1] : 0.f;
        pw[stt][ct][r2] = cvtpk(v0, v1);
      }
  f32x16 oa[2];
#pragma unroll
  for (int r = 0; r < 16; ++r) { oa[0][r] = 0.f; oa[1][r] = 0.f; }
  const u16* vrow = gvT + ((size_t)bh * 128 + 32 * w + r32) * L + 64 * n;
#pragma unroll
  for (int stt = 0; stt < 2; ++stt)
#pragma unroll
    for (int s2 = 0; s2 < 2; ++s2) {
      const u32x2 lo = *(const u32x2*)(vrow + 32 * stt + 16 * s2 + 4 * hh), hi = *(const u32x2*)(vrow + 32 * stt + 16 * s2 + 8 + 4 * hh);
      const bf16x8 vf = asbf(u32x4{lo[0], lo[1], hi[0], hi[1]});
#pragma unroll
      for (int ct = 0; ct < 2; ++ct) {
        const bf16x8 pf = asbf(u32x4{pw[stt][ct][4 * s2], pw[stt][ct][4 * s2 + 1], pw[stt][ct][4 * s2 + 2], pw[stt][ct][4 * s2 + 3]});
        oa[ct] = MFMA(vf, pf, oa[ct]);
      }
    }
  const float* srow = st + (((size_t)bh * NCH + n) * 128 + 32 * w + r32) * 64 + 8 * hh;
#pragma unroll
  for (int ks = 0; ks < 4; ++ks) {
    const f32x4 s0 = *(const f32x4*)(srow + 16 * ks), s1 = *(const f32x4*)(srow + 16 * ks + 4);
    const bf16x8 sf = asbf(u32x4{cvtpk(s0[0], s0[1]), cvtpk(s0[2], s0[3]), cvtpk(s1[0], s1[1]), cvtpk(s1[2], s1[3])});
#pragma unroll
    for (int ct = 0; ct < 2; ++ct) {
      const bf16x8 qf = *(const bf16x8*)(QD + (32 * ct + r32) * 72 + 16 * ks + 8 * hh);
      oa[ct] = MFMA(sf, qf, oa[ct]);
    }
  }
#pragma unroll
  for (int ct = 0; ct < 2; ++ct) { float s = 0.f;
#pragma unroll
    for (int r = 0; r < 16; ++r) s += oa[ct][r] * oa[ct][r];
    part[(2 * w + hh) * 64 + 32 * ct + r32] = s; }
  __syncthreads();
#pragma unroll
  for (int ct = 0; ct < 2; ++ct) {
    const int c = 32 * ct + r32; float tot = 0.f;
#pragma unroll
    for (int i = 0; i < 8; ++i) tot += part[i * 64 + c];
    const float rn = rsqrtf(tot * (1.f / 128.f) + LN_EPS);
    const size_t t = (size_t)b * L + 64 * n + c;
#pragma unroll
    for (int g = 0; g < 4; ++g) {
      const int vd = 32 * w + 8 * g + 4 * hh; const int cc = hd * 128 + vd;
      const u32x2 rr = *(const u32x2*)(gr + t * 512 + cc);
      const float rv[4] = {bflo(rr[0]), bfhi(rr[0]), bflo(rr[1]), bfhi(rr[1])};
      float ov[4];
#pragma unroll
      for (int i = 0; i < 4; ++i) { const float sl = rv[i] / (1.f + __expf(-rv[i])); ov[i] = oa[ct][4 * g + i] * rn * p.gng[cc + i] * sl; }
      *(u32x2*)(o + t * 1024 + cc) = u32x2{cvtpk(ov[0], ov[1]), cvtpk(ov[2], ov[3])};
    }
  }
  __syncthreads();
}

DEV void fox_attn_item(const Params& p, int b, int h, int qb, char* lds) {
  u16* Ks = (u16*)lds;
  u16* Ka = Ks + 64 * 72;
  u16* Vs = Ka + 64 * 24;
  const int tid = TIDX(), lane = tid & 63, w = __builtin_amdgcn_readfirstlane(tid >> 6), r32 = lane & 31, hh = lane >> 5;
  const size_t bh = (size_t)b * 8 + h;
  const u16* fq = (const u16*)(p.ws + A_FQ) + bh * L * 64; const u16* fk = (const u16*)(p.ws + A_FK) + bh * L * 64;
  const u16* fvT = (const u16*)(p.ws + A_FVT) + bh * 64 * L;
  const u16* qaug = (const u16*)(p.ws + A_QAUG) + bh * L * 16; const u16* kaug = (const u16*)(p.ws + A_KAUG) + bh * L * 16;
  u16* o = (u16*)(p.ws + OFF_O);
  const int ql = 128 * qb + 32 * w + r32;
  bf16x8 qf[5];
#pragma unroll
  for (int d0 = 0; d0 < 4; ++d0) qf[d0] = *(const bf16x8*)(fq + (size_t)ql * 64 + 16 * d0 + 8 * hh);
  qf[4] = *(const bf16x8*)(qaug + (size_t)ql * 16 + 8 * hh);
  f32x16 o0, o1;
#pragma unroll
  for (int r = 0; r < 16; ++r) { o0[r] = 0.f; o1[r] = 0.f; }
  float m = -1e30f, lsum = 0.f;
  const int wqmin = 128 * qb + 32 * w, wqmax = wqmin + 31;
  const int kt_hi = 2 * qb + 1, kt_lo = 1;
  u32x4 rk[2], rv[2], rka;
  const int krow = tid >> 3, kch = tid & 7;
  volatile int* doneflag = (volatile int*)(lds + 55296 + 16);
  const float* c2p = (const float*)(p.ws + A_C2) + bh * L;
  const unsigned* bar = (const unsigned*)(p.ws + OFF_BAR);
  const float U = sqrtf(__uint_as_float(bar[BAR_QN + bh]) * __uint_as_float(bar[BAR_KN + bh]));
  const float cqb = c2p[128 * qb];
  int mydone = 0;
  auto gload = [&](int kt) {
#pragma unroll
    for (int i = 0; i < 2; ++i) {
      rk[i] = *(const u32x4*)(fk + (size_t)(64 * kt + krow + 32 * i) * 64 + 8 * kch);
      rv[i] = *(const u32x4*)(fvT + (size_t)(krow + 32 * i) * L + 64 * kt + 8 * kch);
    }
    if (tid < 128) rka = *(const u32x4*)(kaug + (size_t)(64 * kt + (tid >> 1)) * 16 + 8 * (tid & 1));
  };
  gload(kt_hi);
  for (int kt = kt_hi; kt >= kt_lo; --kt) {
    if (!mydone && kt < 2 * qb) {
      float mm = m;
#pragma unroll
      for (int o = 16; o > 0; o >>= 1) mm = fminf(mm, __shfl_xor(mm, o));
      if (cqb - c2p[64 * kt + 63] + U < mm - 40.f) mydone = 1;
    }
    if (lane == 0) doneflag[w] = mydone;
    __syncthreads();
    if (doneflag[0] + doneflag[1] + doneflag[2] + doneflag[3] == 4) break;
#pragma unroll
    for (int i = 0; i < 2; ++i) {
      *(u32x4*)(Ks + (krow + 32 * i) * 72 + 8 * kch) = rk[i];
      u16* vd = Vs + (krow + 32 * i) * 68 + 8 * kch;
      *(u32x2*)vd = u32x2{rv[i][0], rv[i][1]}; *(u32x2*)(vd + 4) = u32x2{rv[i][2], rv[i][3]};
    }
    if (tid < 128) { u16* kd = Ka + (tid >> 1) * 24 + 8 * (tid & 1); *(u32x4*)kd = rka; }
    __syncthreads();
    if (kt > kt_lo) gload(kt - 1);
    if (64 * kt <= wqmax && !mydone) {
      f32x16 s0, s1;
#pragma unroll
      for (int r = 0; r < 16; ++r) { s0[r] = 0.f; s1[r] = 0.f; }
#pragma unroll
      for (int d0 = 0; d0 < 4; ++d0) {
        const bf16x8 k0 = *(const bf16x8*)(Ks + r32 * 72 + 16 * d0 + 8 * hh), k1 = *(const bf16x8*)(Ks + (32 + r32) * 72 + 16 * d0 + 8 * hh);
        s0 = MFMA(k0, qf[d0], s0); s1 = MFMA(k1, qf[d0], s1);
      }
      {
        const bf16x8 k0 = *(const bf16x8*)(Ka + r32 * 24 + 8 * hh), k1 = *(const bf16x8*)(Ka + (32 + r32) * 24 + 8 * hh);
        s0 = MFMA(k0, qf[4], s0); s1 = MFMA(k1, qf[4], s1);
      }
      if (kt == 1 || 64 * kt + 63 > wqmin) {
#pragma unroll
        for (int r = 0; r < 16; ++r) {
          const int k0 = 64 * kt + crow(r, hh), k1 = k0 + 32;
          if (!(k0 <= ql && k0 >= NPAD)) s0[r] = -1e30f;
          if (!(k1 <= ql && k1 >= NPAD)) s1[r] = -1e30f;
        }
      }
      float rm = fmaxf(s0[0], s1[0]);
#pragma unroll
      for (int r = 1; r < 16; ++r) rm = fmaxf(rm, fmaxf(s0[r], s1[r]));
      rm = fmaxf(rm, __shfl_xor(rm, 32));
      const float mn = fmaxf(m, rm); const float alpha = __builtin_amdgcn_exp2f(m - mn); m = mn;
      float ps = 0.f;
#pragma unroll
      for (int r = 0; r < 16; ++r) { s0[r] = __builtin_amdgcn_exp2f(s0[r] - mn); s1[r] = __builtin_amdgcn_exp2f(s1[r] - mn); ps += s0[r] + s1[r]; }
      lsum = lsum * alpha + ps;
#pragma unroll
      for (int r = 0; r < 16; ++r) { o0[r] *= alpha; o1[r] *= alpha; }
      unsigned pw0[8], pw1[8];
#pragma unroll
      for (int i = 0; i < 8; ++i) { pw0[i] = cvtpk(s0[2 * i], s0[2 * i + 1]); pw1[i] = cvtpk(s1[2 * i], s1[2 * i + 1]); }
#pragma unroll
      for (int nk = 0; nk < 2; ++nk)
#pragma unroll
        for (int s2 = 0; s2 < 2; ++s2) {
          const bf16x8 pf = nk ? asbf(u32x4{pw1[4 * s2], pw1[4 * s2 + 1], pw1[4 * s2 + 2], pw1[4 * s2 + 3]}) : asbf(u32x4{pw0[4 * s2], pw0[4 * s2 + 1], pw0[4 * s2 + 2], pw0[4 * s2 + 3]});
          {
            const u16* vb = Vs + r32 * 68 + 32 * nk + 16 * s2 + 4 * hh;
            const u32x2 lo = *(const u32x2*)vb, hi = *(const u32x2*)(vb + 8);
            o0 = MFMA(asbf(u32x4{lo[0], lo[1], hi[0], hi[1]}), pf, o0);
          }
          {
            const u16* vb = Vs + (32 + r32) * 68 + 32 * nk + 16 * s2 + 4 * hh;
            const u32x2 lo = *(const u32x2*)vb, hi = *(const u32x2*)(vb + 8);
            o1 = MFMA(asbf(u32x4{lo[0], lo[1], hi[0], hi[1]}), pf, o1);
          }
        }
    }
  }
  const float ltot = lsum + __shfl_xor(lsum, 32); const float inv = 1.f / ltot;
  float ssq = 0.f;
#pragma unroll
  for (int r = 0; r < 16; ++r) { o0[r] *= inv; o1[r] *= inv; ssq += o0[r] * o0[r] + o1[r] * o1[r]; }
  ssq += __shfl_xor(ssq, 32);
  const float rn = rsqrtf(ssq * (1.f / 64.f) + LN_EPS);
  const size_t t = (size_t)b * L + ql;
#pragma unroll
  for (int dt = 0; dt < 2; ++dt)
#pragma unroll
    for (int g = 0; g < 4; ++g) {
      const int d = 32 * dt + 8 * g + 4 * hh; const int cc = h * 64 + d;
      float ov[4];
#pragma unroll
      for (int i = 0; i < 4; ++i) ov[i] = (dt ? o1[4 * g + i] : o0[4 * g + i]) * rn * p.fng[cc + i];
      *(u32x2*)(o + t * 1024 + 512 + cc) = u32x2{cvtpk(ov[0], ov[1]), cvtpk(ov[2], ov[3])};
    }
  __syncthreads();
}
DEV int next_item(unsigned* ctr, volatile int* slot) {
  __syncthreads();
  if (TIDX() == 0) *slot = (int)atomicAdd(ctr, 1u);
  __syncthreads();
  return *slot;
}
DEV void phase_mix(const Params& p0, char* lds) {
  const int n_at = NB * 8 * 32, n_g3 = NB * 4 * 64;
  volatile int* slot = (volatile int*)(lds + 55296);
  {
    Params p = p0; { size_t z = 0; asm volatile("" : "+s"(z) :: "memory"); p.ws = p0.ws + z; }
    unsigned* ctr = (unsigned*)(p.ws + OFF_BAR) + BAR_WQ;
#pragma unroll 1
    for (int it = next_item(ctr, slot); it < n_at; it = next_item(ctr, slot)) { const int qb = 32 - (it >> 6), bh = it & 63; fox_attn_item(p, bh >> 3, bh & 7, qb, lds); }
  }
  {
    Params p = p0; { size_t z = 0; asm volatile("" : "+s"(z) :: "memory"); p.ws = p0.ws + z; }
    unsigned* ctr = (unsigned*)(p.ws + OFF_BAR) + BAR_WQ + 1;
#pragma unroll 1
    for (int i = next_item(ctr, slot); i < n_g3; i = next_item(ctr, slot)) { const int bh = i >> 6, n = 2 + (i & 63); gla_g3_item(p, bh >> 2, bh & 3, n, lds); }
  }
}

DEV int real_mtile(int i) { return (i >> 5) * 33 + 1 + (i & 31); }
DEV int real_m0(int i) { return (i >> 4) * L + 128 + (i & 15) * 256; }
DEV void phase_outproj(const Params& p, char* lds) {
  const u16* o = (const u16*)(p.ws + OFF_O); const u16* woutT = (const u16*)(p.ws + OFF_WOUTT); const u16* h0 = (const u16*)(p.ws + OFF_H0);
  float* pre1 = (float*)(p.ws + OFF_A);
  for (int tile = blockIdx.x; tile < 128 * 8; tile += gridDim.x) {
    const int m0 = real_m0(tile >> 3), nt = tile & 7;
    gemm_tile<4>(o, 1024, woutT, 1024, 1024, m0, nt * 128, lds, [&](int row, int col, float v0, float v1, float v2, float v3) __attribute__((always_inline)) {
      const float v[4] = {v0, v1, v2, v3};
#pragma unroll
      for (int i = 0; i < 4; ++i) { const size_t e = (size_t)(row + i) * 1024 + col; pre1[e] = DN_ALPHA * bf2f(h0[e]) + v[i]; }
    });
  }
}

DEV void quant_rows(const Params& p, int wi, int lane) {
  unsigned char* tq = (unsigned char*)(p.ws + OFF_TBL); float* tsc = (float*)(p.ws + OFF_TBL + TBL_SC);
  const int r = 2 * wi + (lane >> 5); const int c = lane & 31;
  const float* src = ((r < 16384) ? p.pu + (size_t)r * 1024 : p.pv + (size_t)(r - 16384) * 1024) + 32 * c;
  v16f a, b;
#pragma unroll
  for (int i = 0; i < 4; ++i) {
    const f32x4 x0 = *(const f32x4*)(src + 4 * i), x1 = *(const f32x4*)(src + 16 + 4 * i);
#pragma unroll
    for (int j = 0; j < 4; ++j) { a[4 * i + j] = x0[j]; b[4 * i + j] = x1[j]; }
  }
  float am = 0.f;
#pragma unroll
  for (int i = 0; i < 16; ++i) am = fmaxf(am, fmaxf(fabsf(a[i]), fabsf(b[i])));
#pragma unroll
  for (int o = 16; o > 0; o >>= 1) am = fmaxf(am, __shfl_xor(am, o));
  const float sc = (am > 0.f) ? am * (1.f / 7.5f) : 1.f; const float isc = 1.f / sc;
#pragma unroll
  for (int i = 0; i < 16; ++i) { a[i] *= isc; b[i] *= isc; }
  {
    const float k4 = 6.f / 7.5f;
    unsigned p4[4] = {0u, 0u, 0u, 0u};
    static_for<0, 32>([&](auto ix) __attribute__((always_inline)) {
      constexpr int i = decltype(ix)::value;
      const float v = ((i < 16) ? a[i & 15] : b[i & 15]) * k4;
      const float av = fabsf(v);
      const unsigned code = (unsigned)(av > 0.25f) + (unsigned)(av > 0.75f) + (unsigned)(av > 1.25f) + (unsigned)(av > 1.75f) + (unsigned)(av > 2.5f) + (unsigned)(av > 3.5f) + (unsigned)(av > 5.f);
      p4[i >> 3] |= (code | ((v < 0.f) ? 8u : 0u)) << (4 * (i & 7));
    });
    *(u32x4*)(tq + (size_t)r * 512 + 16 * c) = u32x4{p4[0], p4[1], p4[2], p4[3]};
    if (c == 0) tsc[r] = sc * (7.5f / 6.f);
    return;
  }
  unsigned pk[6] = {0u, 0u, 0u, 0u, 0u, 0u};
  static_for<0, 32>([&](auto ix) __attribute__((always_inline)) {
    constexpr int i = decltype(ix)::value;
    const float v = (i < 16) ? a[i & 15] : b[i & 15];
    const float av = fabsf(v);
    float cf = (av < 2.f) ? av * 8.f : ((av < 4.f) ? 16.f + (av - 2.f) * 4.f : 24.f + (av - 4.f) * 2.f);
    unsigned code = (unsigned)(int)rintf(cf); code = code > 31u ? 31u : code;
    const unsigned f = code | ((v < 0.f) ? 32u : 0u);
    constexpr int bp = 6 * i, di = bp >> 5, off = bp & 31;
    pk[di] |= f << off;
    if constexpr (off > 26) pk[di + 1] |= f >> (32 - off);
  });
  u32x2* dst = (u32x2*)(tq + TBL_V + (size_t)(r - 16384) * 768 + 24 * c);
  dst[0] = u32x2{pk[0], pk[1]}; dst[1] = u32x2{pk[2], pk[3]}; dst[2] = u32x2{pk[4], pk[5]};
  if (c == 0) tsc[r] = sc;
}
DEV void phase_ln1(const Params& p) {
  const float* pre1 = (const float*)(p.ws + OFF_A); u16* h1 = (u16*)(p.ws + OFF_ST);
  const int tid = TIDX(); const int lane = tid & 63, wv = __builtin_amdgcn_readfirstlane(tid >> 6);
  for (int it = blockIdx.x; it < 32768 / 4; it += gridDim.x) {
    const int ti = it * 4 + wv; const int t = (ti >> 12) * L + 128 + (ti & 4095);
    ln_row_to_bf16(pre1 + (size_t)t * 1024, p.ln1g, p.ln1b, h1 + (size_t)t * 1024, lane);
  }
}

DEV void phase_peerq(const Params& p, char* lds) {
  const u16* h1 = (const u16*)(p.ws + OFF_ST); const u16* wqT = (const u16*)(p.ws + OFF_WQT); u16* qp = (u16*)(p.ws + OFF_A);
  const bool xa = (gridDim.x & 7) == 0;
  for (int tile = blockIdx.x; tile < 128 * 16; tile += gridDim.x) {
    const int mt_ = xa ? (tile >> 4) : (tile >> 4), nt = xa ? ((tile & 7) + 8 * ((tile >> 3) & 1)) : (tile & 15);
    const int m0 = real_m0(mt_);
    gemm_tile<4>(h1, 1024, wqT, 1024, 1024, m0, nt * 128, lds, [&](int row, int col, float v0, float v1, float v2, float v3) __attribute__((always_inline)) {
      u16* dst = qp + (size_t)row * 2048 + col;
      dst[0] = f2bf(v0); dst[2048] = f2bf(v1); dst[4096] = f2bf(v2); dst[6144] = f2bf(v3);
    });
  }
}

DEV unsigned fkey(float f) { const unsigned u = __float_as_uint(f); return (u & 0x80000000u) ? ~u : (u | 0x80000000u); }
DEV float kval(unsigned k) { const unsigned u = (k & 0x80000000u) ? (k & 0x7fffffffu) : ~k; return __uint_as_float(u); }
DEV void ins16(unsigned (&Lst)[16], unsigned x) {
#pragma unroll
  for (int i = 0; i < 16; ++i) { const unsigned hi = max(Lst[i], x); x = min(Lst[i], x); Lst[i] = hi; }
}
DEV void cswap_desc(unsigned& a, unsigned& b) { const unsigned hi = max(a, b), lo = min(a, b); a = hi; b = lo; }
template <int K, int J> DEV void bstage(unsigned (&a)[16]) {
  static_for<0, 16>([&](auto ix) __attribute__((always_inline)) {
    constexpr int i = decltype(ix)::value; constexpr int l = i ^ J;
    if constexpr (l > i) {
      const unsigned hi = max(a[i], a[l]), lo = min(a[i], a[l]);
      if constexpr ((i & K) == 0) { a[i] = hi; a[l] = lo; } else { a[i] = lo; a[l] = hi; }
    }
  });
}
DEV void sort16_desc(unsigned (&a)[16]) {
  bstage<2, 1>(a); bstage<4, 2>(a); bstage<4, 1>(a); bstage<8, 4>(a); bstage<8, 2>(a); bstage<8, 1>(a);
  bstage<16, 8>(a); bstage<16, 4>(a); bstage<16, 2>(a); bstage<16, 1>(a);
}
DEV void merge16_desc(unsigned (&a)[16], const unsigned (&b)[16]) {
#pragma unroll
  for (int i = 0; i < 16; ++i) a[i] = max(a[i], b[15 - i]);
  bstage<16, 8>(a); bstage<16, 4>(a); bstage<16, 2>(a); bstage<16, 1>(a);
}
constexpr int C1I[16] = {1, 1, 1, 1, 1, 1, 1, 1, 2, 2, 2, 2, 2, 4, 4, 4}, C1J[16] = {0, 1, 2, 3, 4, 5, 6, 7, 0, 1, 2, 3, 4, 0, 1, 2};
constexpr int C2I[16] = {3, 3, 3, 3, 5, 5, 6, 6, 7, 7, 8, 9, 10, 11, 12, 13}, C2J[16] = {0, 1, 2, 3, 0, 1, 0, 1, 0, 1, 0, 0, 0, 0, 0, 0};
DEV void phase_topk(const Params& p, char* lds) {
  u16* KS = (u16*)lds;
  const u16* keys = (const u16*)(p.ws + OFF_KEYS); const u16* qp = (const u16*)(p.ws + OFF_A);
  int* experts = (int*)(p.ws + OFF_O); float* gates = (float*)(p.ws + OFF_O + (size_t)T * 128 * 4);
  const int tid = TIDX(), lane = tid & 63, w = __builtin_amdgcn_readfirstlane(tid >> 6), r32 = lane & 31, hh = lane >> 5;
  u32x4 kreg[8];
  auto kload = [&](int hc) __attribute__((always_inline)) {
#pragma unroll
    for (int i = 0; i < 8; ++i) { const int id = tid + 256 * i; const int row = id >> 4, ch = id & 15;
      kreg[i] = *(const u32x4*)(keys + ((size_t)hc * 128 + row) * 128 + 8 * ch); }
  };
  if ((int)blockIdx.x < 2048) kload(2 * ((int)blockIdx.x & 7));
#pragma unroll 1
  for (int it = blockIdx.x; it < 2048; it += gridDim.x) {
    const int m0 = real_mtile(it >> 3) * 128; const size_t t = (size_t)m0 + 32 * w + r32;
    const int h = it & 7;
    {
      unsigned LA[16], LB[16];
#pragma unroll
      for (int i = 0; i < 16; ++i) { LA[i] = 0u; LB[i] = 0u; }
#pragma unroll 1
      for (int c = 0; c < 2; ++c) {
        const int hc = 2 * h + c;
        const u16* qrow = qp + t * 2048 + hc * 128 + 8 * hh;
        bf16x8 qf[8];
#pragma unroll
        for (int ks = 0; ks < 8; ++ks) qf[ks] = *(const bf16x8*)(qrow + 16 * ks);
        __syncthreads();
#pragma unroll
        for (int i = 0; i < 8; ++i) { const int id = tid + 256 * i; const int row = id >> 4, ch = id & 15;
          *(u32x4*)(KS + row * 136 + 8 * ch) = kreg[i]; }
        __syncthreads();
        { const int nit = it + (int)gridDim.x; if (c == 0) kload(hc + 1); else if (nit < 2048) kload(2 * (nit & 7)); }
        unsigned Lc[16];
#pragma unroll
        for (int i = 0; i < 16; ++i) Lc[i] = 0u;
#pragma unroll 1
        for (int kt = 0; kt < 4; ++kt) {
          f32x16 acc;
#pragma unroll
          for (int r = 0; r < 16; ++r) acc[r] = 0.f;
#pragma unroll
          for (int ks = 0; ks < 8; ++ks) acc = MFMA(*(const bf16x8*)(KS + (32 * kt + r32) * 136 + 16 * ks + 8 * hh), qf[ks], acc);
          unsigned kb[16];
#pragma unroll
          for (int r = 0; r < 16; ++r) kb[r] = (fkey(acc[r]) & ~127u) | (unsigned)(32 * kt + crow(r, hh));
          sort16_desc(kb);
          merge16_desc(Lc, kb);
        }
        unsigned M[16];
#pragma unroll
        for (int i = 0; i < 16; ++i) M[i] = max(Lc[i], (unsigned)__shfl_xor((int)Lc[15 - i], 32));
        bstage<16, 8>(M); bstage<16, 4>(M); bstage<16, 2>(M); bstage<16, 1>(M);
#pragma unroll
        for (int i = 0; i < 16; ++i) { LA[i] = LB[i]; LB[i] = M[i]; }
      }
      unsigned H2[16], Hb[16];
      {
        float fa[16], fb[16];
#pragma unroll
        for (int i = 0; i < 16; ++i) { fa[i] = kval(LA[i] & ~127u); fb[i] = kval(LB[i] & ~127u); }
#pragma unroll
        for (int j = 0; j < 16; ++j) H2[j] = (fkey(fa[0] + fb[j]) & ~255u) | (unsigned)j;
        sort16_desc(H2);
        static_for<0, 16>([&](auto ix) __attribute__((always_inline)) { constexpr int e = decltype(ix)::value; constexpr int i = C1I[e], j = C1J[e];
          Hb[e] = (fkey(fa[i] + fb[j]) & ~255u) | (unsigned)(i * 16 + j); });
        sort16_desc(Hb); merge16_desc(H2, Hb);
        static_for<0, 16>([&](auto ix) __attribute__((always_inline)) { constexpr int e = decltype(ix)::value; constexpr int i = C2I[e], j = C2J[e];
          Hb[e] = (fkey(fa[i] + fb[j]) & ~255u) | (unsigned)(i * 16 + j); });
        sort16_desc(Hb); merge16_desc(H2, Hb);
        ins16(H2, (fkey(fa[14] + fb[0]) & ~255u) | (unsigned)(14 * 16));
        ins16(H2, (fkey(fa[15] + fb[0]) & ~255u) | (unsigned)(15 * 16));
      }
      unsigned char* tab = (unsigned char*)(lds + 34816) + (w * 32 + r32) * 32;
      if (hh == 0) {
        unsigned pk[8];
#pragma unroll
        for (int i = 0; i < 4; ++i) {
          pk[i] = (LA[4 * i] & 127u) | ((LA[4 * i + 1] & 127u) << 8) | ((LA[4 * i + 2] & 127u) << 16) | ((LA[4 * i + 3] & 127u) << 24);
          pk[4 + i] = (LB[4 * i] & 127u) | ((LB[4 * i + 1] & 127u) << 8) | ((LB[4 * i + 2] & 127u) << 16) | ((LB[4 * i + 3] & 127u) << 24);
        }
        *(u32x4*)tab = u32x4{pk[0], pk[1], pk[2], pk[3]}; *(u32x4*)(tab + 16) = u32x4{pk[4], pk[5], pk[6], pk[7]};
      }
      const float mx = kval(H2[0] & ~255u); float Z = 0.f;
#pragma unroll
      for (int i = 0; i < 16; ++i) Z += __expf(kval(H2[i] & ~255u) - mx);
      const float iz = 1.f / Z;
      int eo[8]; float go[8];
#pragma unroll
      for (int i = 0; i < 8; ++i) {
        const unsigned sel = hh ? 0xffffffffu : 0u;
        const unsigned key = (H2[8 + i] & sel) | (H2[i] & ~sel);
        const unsigned cid = key & 255u;
        eo[i] = (int)tab[cid >> 4] * 128 + (int)tab[16 + (cid & 15u)];
        go[i] = __expf(kval(key & ~255u) - mx) * iz;
      }
      int* ed = experts + t * 128 + h * 16 + 8 * hh; float* gd = gates + t * 128 + h * 16 + 8 * hh;
      *(u32x4*)ed = u32x4{(unsigned)eo[0], (unsigned)eo[1], (unsigned)eo[2], (unsigned)eo[3]}; *(u32x4*)(ed + 4) = u32x4{(unsigned)eo[4], (unsigned)eo[5], (unsigned)eo[6], (unsigned)eo[7]};
      *(f32x4*)gd = f32x4{go[0], go[1], go[2], go[3]}; *(f32x4*)(gd + 4) = f32x4{go[4], go[5], go[6], go[7]};
    }
  }
}

DEV v32f swdec(const v6u& d) {
  v32f o;
  static_for<0, 32>([&](auto ix) __attribute__((always_inline)) {
    constexpr int i = decltype(ix)::value; constexpr int bp = 6 * i, di = bp >> 5, off = bp & 31;
    unsigned f = d[di] >> off;
    if constexpr (off > 26) f |= d[di + 1] << (32 - off);
    f &= 63u;
    const unsigned code = f & 31u; const unsigned e = code >> 3, m = code & 7u;
    float v = (e == 0) ? (float)m * 0.125f : (1.f + (float)m * 0.125f) * (float)(1u << (e - 1));
    o[i] = (f & 32u) ? -v : v;
  });
  return o;
}
DEV v6u ld_row(const unsigned char* p) { const u32x2* q = (const u32x2*)p; const u32x2 a = q[0], b = q[1], c = q[2]; return v6u{a[0], a[1], b[0], b[1], c[0], c[1]}; }
DEV void phase_experts(const Params& p) {
  const u16* h1 = (const u16*)(p.ws + OFF_ST);
  const unsigned char* uq = (const unsigned char*)(p.ws + OFF_TBL + TBL_U); const unsigned char* vq = (const unsigned char*)(p.ws + OFF_TBL + TBL_V);
  const float* tsc = (const float*)(p.ws + OFF_TBL + TBL_SC);
  const int* experts = (const int*)(p.ws + OFF_O); const float* gates = (const float*)(p.ws + OFF_O + (size_t)T * 128 * 4);
  const int tid_ = TIDX(); const int lane = tid_ & 63, w = __builtin_amdgcn_readfirstlane(tid_ >> 6);
  const int c = lane & 31; const bool hi = lane >= 32;
  const int b4 = (lane >> 4) & 1, b3 = (lane >> 3) & 1, b2 = (lane >> 2) & 1, b1 = (lane >> 1) & 1;
  const int kofs = 2 * ((lane >> 1) & 15) + (lane >> 5);
  for (int ti = blockIdx.x * 4 + w; ti < 32768; ti += gridDim.x * 4) {
    const size_t t = (size_t)(ti >> 12) * L + 128 + (ti & 4095);
    unsigned xb[16];
#pragma unroll
    for (int i = 0; i < 4; ++i) { const u32x4 q = *(const u32x4*)(h1 + t * 1024 + 32 * c + 8 * i); xb[4 * i] = q[0]; xb[4 * i + 1] = q[1]; xb[4 * i + 2] = q[2]; xb[4 * i + 3] = q[3]; }
    f32x2 yp[16];
#pragma unroll
    for (int i = 0; i < 16; ++i) yp[i] = f32x2{0.f, 0.f};
    f32x2 xp[16];
#pragma unroll
    for (int i = 0; i < 16; ++i) xp[i] = f32x2{bflo(xb[i]), bfhi(xb[i])};
#pragma unroll 1
    for (int bt = 0; bt < 4; ++bt) {
      const int emine = experts[t * 128 + 32 * bt + kofs]; const float gmine = gates[t * 128 + 32 * bt + kofs];
      const float su = tsc[emine], sv = tsc[16384 + emine];
      float pd[16];
      u32x4 Rv[16];
      {
        u32x4 Ru[16];
#pragma unroll
        for (int j = 0; j < 16; ++j) {
          const int e0 = __builtin_amdgcn_readlane(emine, 2 * j), e1 = __builtin_amdgcn_readlane(emine, 32 + 2 * j);
          Ru[j] = *(const u32x4*)(uq + (size_t)(hi ? e1 : e0) * 512 + 16 * c);
        }
#pragma unroll
        for (int j = 0; j < 16; ++j) {
          const int e0 = __builtin_amdgcn_readlane(emine, 2 * j), e1 = __builtin_amdgcn_readlane(emine, 32 + 2 * j);
          Rv[j] = *(const u32x4*)(vq + (size_t)(hi ? e1 : e0) * 512 + 16 * c);
        }
        __builtin_amdgcn_sched_barrier(0);
#pragma unroll
        for (int j = 0; j < 16; ++j) {
          f32x2 a2 = {0.f, 0.f}, a3 = {0.f, 0.f};
#pragma unroll
          for (int d = 0; d < 4; ++d) {
            a2 = __builtin_elementwise_fma(__builtin_amdgcn_cvt_scalef32_pk_f32_fp4(Ru[j][d], 1.0f, 0), xp[4 * d], a2);
            a3 = __builtin_elementwise_fma(__builtin_amdgcn_cvt_scalef32_pk_f32_fp4(Ru[j][d], 1.0f, 1), xp[4 * d + 1], a3);
            a2 = __builtin_elementwise_fma(__builtin_amdgcn_cvt_scalef32_pk_f32_fp4(Ru[j][d], 1.0f, 2), xp[4 * d + 2], a2);
            a3 = __builtin_elementwise_fma(__builtin_amdgcn_cvt_scalef32_pk_f32_fp4(Ru[j][d], 1.0f, 3), xp[4 * d + 3], a3);
          }
          pd[j] = (a2[0] + a2[1]) + (a3[0] + a3[1]);
        }
      }
#pragma unroll
      for (int i = 0; i < 8; ++i) { const float snd = b4 ? pd[i] : pd[i + 8], kp = b4 ? pd[i + 8] : pd[i]; pd[i] = kp + __shfl_xor(snd, 16); }
#pragma unroll
      for (int i = 0; i < 4; ++i) { const float snd = b3 ? pd[i] : pd[i + 4], kp = b3 ? pd[i + 4] : pd[i]; pd[i] = kp + __shfl_xor(snd, 8); }
#pragma unroll
      for (int i = 0; i < 2; ++i) { const float snd = b2 ? pd[i] : pd[i + 2], kp = b2 ? pd[i + 2] : pd[i]; pd[i] = kp + __shfl_xor(snd, 4); }
      { const float snd = b1 ? pd[0] : pd[1], kp = b1 ? pd[1] : pd[0]; pd[0] = kp + __shfl_xor(snd, 2); }
      const float dv = (pd[0] + __shfl_xor(pd[0], 1)) * su;
      const float act = 0.5f * dv * (1.f + erff(dv * 0.7071067811865476f));
      const float wg = gmine * act * sv;
      {
#pragma unroll
        for (int j = 0; j < 16; ++j) {
          const float w0 = __uint_as_float(__builtin_amdgcn_readlane(__float_as_uint(wg), 2 * j)), w1 = __uint_as_float(__builtin_amdgcn_readlane(__float_as_uint(wg), 32 + 2 * j));
          const float ws = hi ? w1 : w0; const f32x2 ws2 = {ws, ws};
#pragma unroll
          for (int d = 0; d < 4; ++d) {
            yp[4 * d] = __builtin_elementwise_fma(__builtin_amdgcn_cvt_scalef32_pk_f32_fp4(Rv[j][d], 1.0f, 0), ws2, yp[4 * d]);
            yp[4 * d + 1] = __builtin_elementwise_fma(__builtin_amdgcn_cvt_scalef32_pk_f32_fp4(Rv[j][d], 1.0f, 1), ws2, yp[4 * d + 1]);
            yp[4 * d + 2] = __builtin_elementwise_fma(__builtin_amdgcn_cvt_scalef32_pk_f32_fp4(Rv[j][d], 1.0f, 2), ws2, yp[4 * d + 2]);
            yp[4 * d + 3] = __builtin_elementwise_fma(__builtin_amdgcn_cvt_scalef32_pk_f32_fp4(Rv[j][d], 1.0f, 3), ws2, yp[4 * d + 3]);
          }
        }
      }
    }
    float z[16];
#pragma unroll
    for (int i = 0; i < 16; ++i) {
      const float ylo = yp[i >> 1][i & 1], yup = yp[8 + (i >> 1)][i & 1];
      const float lo = ylo + __shfl_xor(ylo, 32), up = yup + __shfl_xor(yup, 32);
      const unsigned xw = hi ? xb[8 + (i >> 1)] : xb[i >> 1];
      const float xv = (i & 1) ? bfhi(xw) : bflo(xw);
      z[i] = DN_ALPHA * xv + (hi ? up : lo);
    }
    float sm = 0.f;
#pragma unroll
    for (int i = 0; i < 16; ++i) sm += z[i];
    const float mu = wsum(sm) * (1.f / 1024.f);
    float q = 0.f;
#pragma unroll
    for (int i = 0; i < 16; ++i) { const float d = z[i] - mu; q += d * d; }
    const float rs = rsqrtf(wsum(q) * (1.f / 1024.f) + LN_EPS);
    const int e0 = 32 * c + (hi ? 16 : 0);
    float* od = p.out + (size_t)ti * 1024 + e0;
    const f32x4* g4 = (const f32x4*)(p.ln2g + e0); const f32x4* bb4 = (const f32x4*)(p.ln2b + e0);
#pragma unroll
    for (int k = 0; k < 4; ++k) {
      const f32x4 g = g4[k], bb = bb4[k]; f32x4 o;
#pragma unroll
      for (int i = 0; i < 4; ++i) o[i] = (z[4 * k + i] - mu) * rs * g[i] + bb[i];
      *(f32x4*)(od + 4 * k) = o;
    }
  }
}

#define XB_TMO      128
#define XB_XCNT(j)  (256  + 64 * (j))
#define XB_XSUB(j)  (1280 + 64 * (j))
#define XB_XGEN(j)  (2304 + 64 * (j))
#define XB_TOP      3328
#define XB_TOPGEN   3392
#define XB_SPIN_CAP (1u << 22)
#define LAS __attribute__((address_space(3)))
DEV unsigned xb_ld(unsigned* p) { return __hip_atomic_load(p, __ATOMIC_RELAXED, __HIP_MEMORY_SCOPE_AGENT); }
DEV unsigned xb_add(unsigned* p, unsigned v) { return __hip_atomic_fetch_add(p, v, __ATOMIC_RELAXED, __HIP_MEMORY_SCOPE_AGENT); }
DEV unsigned xb_xcc_id() { return (unsigned)__builtin_amdgcn_s_getreg((3 << 11) | 20) & 0xFu; }
#define XB_SPIN(cond, bar) do { unsigned _sp = 0; while (cond) { __builtin_amdgcn_s_sleep(1); \
    if ((++_sp & 255u) == 0u) { if (xb_ld(&(bar)[XB_TMO])) break; if (_sp > XB_SPIN_CAP) { atomicAdd(&(bar)[XB_TMO], 1u); break; } } } } while (0)
struct XcdBarrier { unsigned* bar; unsigned x; volatile LAS unsigned* st; };
DEV XcdBarrier xcd_barrier_post(unsigned* bar, volatile LAS unsigned* st) {
  XcdBarrier b; b.bar = bar; b.x = xb_xcc_id(); b.st = st;
  if (threadIdx.x == 0) (void)xb_add(&bar[XB_XCNT(b.x)], 1u);
  return b;
}
DEV void xcd_barrier_complete(unsigned* bar, unsigned x, unsigned& nloc, unsigned& nx) {
  const unsigned G = gridDim.x;
  unsigned sum, cnt, mine, sp = 0u;
  for (;;) {
    sum = 0u; cnt = 0u; mine = 0u;
#pragma unroll
    for (unsigned j = 0; j < 16; ++j) { const unsigned c = xb_ld(&bar[XB_XCNT(j)]); sum += c; cnt += (c > 0u) ? 1u : 0u; mine = (j == x) ? c : mine; }
    if (sum == G) break;
    __builtin_amdgcn_s_sleep(1);
    if ((++sp & 255u) == 0u) { if (xb_ld(&bar[XB_TMO])) break; if (sp > XB_SPIN_CAP) { atomicAdd(&bar[XB_TMO], 1u); break; } }
  }
  nloc = mine > 0u ? mine : 1u; nx = cnt > 0u ? cnt : 1u;
}
DEV void xcd_barrier(const XcdBarrier& b) {
  asm volatile("s_waitcnt vmcnt(0)" ::: "memory");
  __syncthreads();
  if (threadIdx.x == 0) {
    unsigned* bar = b.bar;
    __builtin_amdgcn_s_waitcnt(0);
    unsigned nloc = b.st[0], nx = b.st[1];
    if (nloc == 0u) { xcd_barrier_complete(bar, b.x, nloc, nx); b.st[0] = nloc; b.st[1] = nx; }
    const unsigned old = xb_add(&bar[XB_XSUB(b.x)], 1u);
    const unsigned gen = old / nloc;
    if (old + 1u == (gen + 1u) * nloc) {
      __builtin_amdgcn_fence(__ATOMIC_RELEASE, "agent");
      asm volatile("s_waitcnt vmcnt(0)" ::: "memory");
      const unsigned og = xb_add(&bar[XB_TOP], 1u);
      const unsigned tg = og / nx;
      if (og + 1u == (tg + 1u) * nx) xb_add(&bar[XB_TOPGEN], 1u);
      else XB_SPIN(xb_ld(&bar[XB_TOPGEN]) == tg, bar);
      __builtin_amdgcn_fence(__ATOMIC_ACQUIRE, "agent");
      xb_add(&bar[XB_XGEN(b.x)], 1u);
      asm volatile("s_waitcnt vmcnt(0)" ::: "memory");
    } else {
      XB_SPIN(xb_ld(&bar[XB_XGEN(b.x)]) == gen, bar);
      __builtin_amdgcn_fence(__ATOMIC_ACQUIRE, "agent");
      asm volatile("s_waitcnt vmcnt(0)" ::: "memory");
    }
  }
  __syncthreads();
}
DEV void grid_barrier(unsigned* ctr, unsigned target) {
  asm volatile("s_waitcnt vmcnt(0)" ::: "memory");
  __syncthreads();
  if (TIDX() == 0) {
    __builtin_amdgcn_fence(__ATOMIC_RELEASE, "agent");
    asm volatile("s_waitcnt vmcnt(0)" ::: "memory");
    __hip_atomic_fetch_add(ctr, 1u, __ATOMIC_RELAXED, __HIP_MEMORY_SCOPE_AGENT);
    while (__hip_atomic_load(ctr, __ATOMIC_RELAXED, __HIP_MEMORY_SCOPE_AGENT) < target) __builtin_amdgcn_s_sleep(2);
    __builtin_amdgcn_fence(__ATOMIC_ACQUIRE, "agent");
    asm volatile("s_waitcnt vmcnt(0)" ::: "memory");
  }
  __syncthreads();
}
constexpr int NPHASE = 10;
constexpr int LDS_BYTES = 55296 + 64;
template <int PH> DEV void run_phase(const Params& p0, char* lds) {
  Params p = p0;
  { size_t z = 0; asm volatile("" : "+s"(z) :: "memory"); p.ws = p0.ws + z; p.out = p0.out + z; }
  if constexpr (PH == 0) phase_prep(p, lds);
  if constexpr (PH == 1) phase_proj(p, lds);
  if constexpr (PH == 2) phase_g1(p, lds);
  if constexpr (PH == 3) phase_scan(p);
  if constexpr (PH == 4) phase_mix(p, lds);
  if constexpr (PH == 5) phase_outproj(p, lds);
  if constexpr (PH == 6) phase_ln1(p);
  if constexpr (PH == 7) phase_peerq(p, lds);
  if constexpr (PH == 8) phase_topk(p, lds);
  if constexpr (PH == 9) phase_experts(p);
}
#if MODE == 0
template <int PH> __global__ void __launch_bounds__(256, 2) phase_kernel(Params p) {
  __shared__ __attribute__((aligned(16))) char lds[LDS_BYTES];
  run_phase<PH>(p, lds);
}
#else
__global__ void __launch_bounds__(256, 2) mega(Params p) {
  __shared__ __attribute__((aligned(16))) char lds[LDS_BYTES];
  cg::grid_group grid = cg::this_grid();
#ifndef PHMASK
#define PHMASK 0x3ff
#endif
#ifndef DUP
#define DUP -1
#endif
#define RUNPH(i) if constexpr ((PHMASK >> i) & 1) { run_phase<i>(p, lds); if constexpr (i == DUP) { __syncthreads(); run_phase<i>(p, lds); } }
  __shared__ uint4 xb_words;
  if (threadIdx.x == 0) xb_words = make_uint4(0u, 0u, 0u, 0u);
  __syncthreads();
  XcdBarrier xb = xcd_barrier_post((unsigned*)(p.ws + OFF_BAR + 4096), (volatile LAS unsigned*)&xb_words);
  if (p.ws == nullptr) grid.sync();
  RUNPH(0); xcd_barrier(xb);
  RUNPH(1); xcd_barrier(xb);
  RUNPH(2); xcd_barrier(xb);
  RUNPH(3); xcd_barrier(xb);
  RUNPH(4); xcd_barrier(xb);
  RUNPH(5); xcd_barrier(xb);
  RUNPH(6); xcd_barrier(xb);
  RUNPH(7); xcd_barrier(xb);
  RUNPH(8); xcd_barrier(xb);
  RUNPH(9);
}
#endif

extern "C" void kernel_launch(void* const* d_in, const int* in_sizes, int n_in, void* d_out, int out_size, void* d_ws, size_t ws_size,
                              hipStream_t stream) {
  Params p{};
  p.x = (const float*)d_in[0]; p.meta = (const float*)d_in[1]; p.eg = (const float*)d_in[2]; p.eb = (const float*)d_in[3];
  p.w_in = (const float*)d_in[4]; p.w_gu = (const float*)d_in[5]; p.b_gate = (const float*)d_in[6]; p.b_forget = (const float*)d_in[7];
  p.gng = (const float*)d_in[8]; p.fng = (const float*)d_in[9]; p.w_out = (const float*)d_in[10]; p.ln1g = (const float*)d_in[11];
  p.ln1b = (const float*)d_in[12]; p.wq = (const float*)d_in[13]; p.subk = (const float*)d_in[14]; p.pu = (const float*)d_in[15];
  p.pv = (const float*)d_in[16]; p.ln2g = (const float*)d_in[17]; p.ln2b = (const float*)d_in[18];
  p.out = (float*)d_out; p.ws = (char*)d_ws;
  if (ws_size < WS_END) { fprintf(stderr, "workspace too small\n"); return; }
#if MODE == 0
  phase_kernel<0><<<dim3(1024), dim3(256), 0, stream>>>(p);
  phase_kernel<1><<<dim3(1024), dim3(256), 0, stream>>>(p);
  phase_kernel<2><<<dim3(1024), dim3(256), 0, stream>>>(p);
  phase_kernel<3><<<dim3(1024), dim3(256), 0, stream>>>(p);
  phase_kernel<4><<<dim3(1024), dim3(256), 0, stream>>>(p);
  phase_kernel<5><<<dim3(1024), dim3(256), 0, stream>>>(p);
  phase_kernel<6><<<dim3(1024), dim3(256), 0, stream>>>(p);
  phase_kernel<7><<<dim3(1024), dim3(256), 0, stream>>>(p);
  phase_kernel<8><<<dim3(256), dim3(256), 0, stream>>>(p);
  phase_kernel<9><<<dim3(2048), dim3(256), 0, stream>>>(p);
#else
  static int grid_blocks = 0;
  if (!grid_blocks) {
    int dev = 0, cus = 0, per_cu = 0;
    hipGetDevice(&dev);
    hipDeviceGetAttribute(&cus, hipDeviceAttributeMultiprocessorCount, dev);
    hipOccupancyMaxActiveBlocksPerMultiprocessor(&per_cu, mega, 256, 0);
    if (per_cu > 2) per_cu = 2;
    grid_blocks = cus * per_cu;
  }
  hipMemsetAsync((char*)d_ws + OFF_BAR, 0, 4096 + 16384, stream);
  void* args[] = {&p};
  hipError_t e = hipLaunchCooperativeKernel((void*)mega, dim3(grid_blocks), dim3(256), args, 0, stream);
  if (e != hipSuccess) fprintf(stderr, "cooperative launch failed: %s (grid %d)\n", hipGetErrorString(e), grid_blocks);
#endif
}
```

```cpp
#include <hip/hip_runtime.h>
#include <hip/hip_cooperative_groups.h>
#include <stdint.h>
#include <stdio.h>
namespace cg = cooperative_groups;

#ifndef MODE
#define MODE 1
#endif

#define DEV __device__ __forceinline__
typedef unsigned short u16;
using bf16x8 = __attribute__((ext_vector_type(8))) short;
using f32x16 = __attribute__((ext_vector_type(16))) float;
using u32x4 = __attribute__((ext_vector_type(4))) unsigned;
using u32x2 = __attribute__((ext_vector_type(2))) unsigned;
using f32x4 = __attribute__((ext_vector_type(4))) float;
using f32x2 = __attribute__((ext_vector_type(2))) float;

constexpr int DM = 1024, NB = 8, SEQ = 4096, L = 4224, T = NB * L, NPAD = 112;
constexpr int NCH = 66;
constexpr int NPROJ = 3200;
constexpr float LN_EPS = 1e-5f;
constexpr float DN_ALPHA = 1.189207115002721f;
constexpr float LOG2E = 1.4426950408889634f;
constexpr float C2 = 0.125f * LOG2E;

constexpr size_t OFF_WINT = 0;
constexpr size_t OFF_WOUTT = OFF_WINT + (size_t)NPROJ * 1024 * 2;
constexpr size_t OFF_WQT = OFF_WOUTT + (size_t)1024 * 1024 * 2;
constexpr size_t OFF_KEYS = OFF_WQT + (size_t)2048 * 1024 * 2;
constexpr size_t OFF_H0 = OFF_KEYS + (size_t)16 * 128 * 128 * 2;
constexpr size_t OFF_A = OFF_H0 + (size_t)T * 1024 * 2;
constexpr size_t A_GQ = OFF_A;
constexpr size_t A_GK = A_GQ + (size_t)NB * 4 * L * 64 * 2;
constexpr size_t A_GVT = A_GK + (size_t)NB * 4 * L * 64 * 2;
constexpr size_t A_GR = A_GVT + (size_t)NB * 4 * 128 * L * 2;
constexpr size_t A_FQ = A_GR + (size_t)T * 512 * 2;
constexpr size_t A_FK = A_FQ + (size_t)NB * 8 * L * 64 * 2;
constexpr size_t A_FVT = A_FK + (size_t)NB * 8 * L * 64 * 2;
constexpr size_t A_QAUG = A_FVT + (size_t)NB * 8 * 64 * L * 2;
constexpr size_t A_KAUG = A_QAUG + (size_t)NB * 8 * L * 16 * 2;
constexpr size_t A_GA = A_KAUG + (size_t)NB * 8 * L * 16 * 2;
constexpr size_t A_LOGF = A_GA + (size_t)T * 16 * 4;
constexpr size_t A_DEC = A_LOGF + (size_t)T * 8 * 4;
constexpr size_t A_C2 = A_DEC + (size_t)NB * 4 * NCH * 64 * 4;
constexpr size_t A_END = A_C2 + (size_t)64 * L * 4;
constexpr size_t OFF_ST = (A_END + 255) & ~(size_t)255;
constexpr size_t OFF_O = OFF_ST + (size_t)T * 1024 * 2;
constexpr size_t OFF_BAR = OFF_O + (size_t)T * 1024 * 2;
constexpr size_t OFF_TBL = OFF_BAR + 4096 + 16384;
constexpr size_t WS_END = OFF_TBL + (size_t)2 * 16384 * 768 + (size_t)2 * 16384 * 4;
constexpr int BAR_QN = 64, BAR_KN = 128, BAR_WQ = 256;
static_assert(WS_END <= (size_t)512 * 1024 * 1024, "workspace");
static_assert((size_t)NB * 4 * NCH * 128 * 64 * 4 == (size_t)T * 1024 * 2, "state size");

struct Params {
  const float *x, *meta, *eg, *eb, *w_in, *w_gu, *b_gate, *b_forget, *gng, *fng, *w_out, *ln1g, *ln1b, *wq, *subk, *pu, *pv, *ln2g, *ln2b;
  float* out; char* ws;
};

typedef unsigned v6u __attribute__((ext_vector_type(6)));
typedef float v16f __attribute__((ext_vector_type(16)));
typedef float v32f __attribute__((ext_vector_type(32)));
typedef __bf16 v32b __attribute__((ext_vector_type(32)));
typedef __bf16 v2b __attribute__((ext_vector_type(2)));
typedef unsigned v16u __attribute__((ext_vector_type(16)));
constexpr size_t TBL_U = 0, TBL_V = (size_t)16384 * 512, TBL_SC = (size_t)2 * 16384 * 512;
DEV int TIDX() { int t = (int)threadIdx.x; asm volatile("" : "+v"(t)); return t; }
typedef __bf16 bf16x2_t __attribute__((ext_vector_type(2)));
DEV unsigned cvtpk(float lo, float hi) { bf16x2_t v = {(__bf16)lo, (__bf16)hi}; return __builtin_bit_cast(unsigned, v); }
DEV u16 f2bf(float f) { return (u16)(cvtpk(f, 0.f) & 0xffffu); }
DEV float bf2f(u16 b) { return __uint_as_float(((unsigned)b) << 16); }
DEV float bflo(unsigned u) { return __uint_as_float(u << 16); }
DEV float bfhi(unsigned u) { return __uint_as_float(u & 0xffff0000u); }
DEV int crow(int r, int hh) { return (r & 3) + 8 * (r >> 2) + 4 * hh; }
DEV float wsum(float v) {
#pragma unroll
  for (int o = 32; o > 0; o >>= 1) v += __shfl_xor(v, o);
  return v;
}
DEV float logsig(float z) { return fminf(z, 0.f) - log1pf(expf(-fabsf(z))); }
#define MFMA(a, b, c) __builtin_amdgcn_mfma_f32_32x32x16_bf16(a, b, c, 0, 0, 0)
DEV bf16x8 asbf(u32x4 v) { return __builtin_bit_cast(bf16x8, v); }

DEV int winmap(int n) {
  if (n < 1536) return n;
  if (n < 3072) return n + 16;
  if (n < 3088) return 1536 + (n - 3072);
  if (n < 3096) return n;
  return -1;
}
template <bool MAP>
DEV void transpose_tile(const float* __restrict__ src, int ldsrc, u16* __restrict__ dst, int k0, int n0, char* lds) {
  float* tl = (float*)lds;
  const int tx = TIDX() & 63, ty = TIDX() >> 6;
  const int n = n0 + tx; const int on = MAP ? winmap(n) : n;
#pragma unroll
  for (int i = 0; i < 16; ++i) { const int k = ty + 4 * i; tl[k * 65 + tx] = (on >= 0) ? src[(size_t)(k0 + k) * ldsrc + on] : 0.f; }
  __syncthreads();
#pragma unroll
  for (int i = 0; i < 16; ++i) { const int nn = ty + 4 * i; dst[(size_t)(n0 + nn) * 1024 + k0 + tx] = f2bf(tl[tx * 65 + nn]); }
  __syncthreads();
}
DEV void ln_row_to_bf16(const float* src, const float* g, const float* bb, u16* dst, int lane) {
  float v[16];
  if (src) {
    const f32x4* s4 = (const f32x4*)src;
    f32x4 a0 = s4[2 * lane], a1 = s4[2 * lane + 1], b0 = s4[128 + 2 * lane], b1 = s4[128 + 2 * lane + 1];
#pragma unroll
    for (int i = 0; i < 4; ++i) { v[i] = a0[i]; v[4 + i] = a1[i]; v[8 + i] = b0[i]; v[12 + i] = b1[i]; }
  } else {
#pragma unroll
    for (int i = 0; i < 16; ++i) v[i] = 0.f;
  }
  float s = 0.f;
#pragma unroll
  for (int i = 0; i < 16; ++i) s += v[i];
  const float mu = wsum(s) * (1.f / 1024.f);
  float q = 0.f;
#pragma unroll
  for (int i = 0; i < 16; ++i) { const float d = v[i] - mu; q += d * d; }
  const float rs = rsqrtf(wsum(q) * (1.f / 1024.f) + LN_EPS);
  unsigned pk[8];
#pragma unroll
  for (int i = 0; i < 8; ++i) {
    const int e0 = (i < 4) ? (8 * lane + 2 * i) : (512 + 8 * lane + 2 * (i - 4));
    const float y0 = (v[2 * i] - mu) * rs * g[e0] + bb[e0];
    const float y1 = (v[2 * i + 1] - mu) * rs * g[e0 + 1] + bb[e0 + 1];
    pk[i] = cvtpk(y0, y1);
  }
  *(u32x4*)(dst + 8 * lane) = u32x4{pk[0], pk[1], pk[2], pk[3]};
  *(u32x4*)(dst + 512 + 8 * lane) = u32x4{pk[4], pk[5], pk[6], pk[7]};
}
DEV void phase_prep(const Params& p, char* lds) {
  u16* winT = (u16*)(p.ws + OFF_WINT); u16* woutT = (u16*)(p.ws + OFF_WOUTT); u16* wqT = (u16*)(p.ws + OFF_WQT);
  u16* keys = (u16*)(p.ws + OFF_KEYS); u16* h0 = (u16*)(p.ws + OFF_H0);
  const int n_win = 50 * 16, n_wout = 16 * 16, n_wq = 32 * 16, n_keys = 128, n_ln = T / 4;
  const int total = n_win + n_wout + n_wq + n_keys + n_ln;
  for (int it = blockIdx.x; it < total; it += gridDim.x) {
    int i = it;
    if (i < n_win) { transpose_tile<true>(p.w_in, 3096, winT, (i & 15) * 64, (i >> 4) * 64, lds); continue; }
    i -= n_win;
    if (i < n_wout) { transpose_tile<false>(p.w_out, 1024, woutT, (i & 15) * 64, (i >> 4) * 64, lds); continue; }
    i -= n_wout;
    if (i < n_wq) { transpose_tile<false>(p.wq, 2048, wqT, (i & 15) * 64, (i >> 4) * 64, lds); continue; }
    i -= n_wq;
    if (i < n_keys) {
      const size_t e = ((size_t)i * 256 + TIDX()) * 8;
      const f32x4 a = *(const f32x4*)(p.subk + e), b = *(const f32x4*)(p.subk + e + 4);
      *(u32x4*)(keys + e) = u32x4{cvtpk(a[0], a[1]), cvtpk(a[2], a[3]), cvtpk(b[0], b[1]), cvtpk(b[2], b[3])};
      continue;
    }
    i -= n_keys;
    {
      const int t = i * 4 + __builtin_amdgcn_readfirstlane(TIDX() >> 6); const int b = t / L, l = t % L;
      const float* src = (l < NPAD) ? nullptr : (l < 128 ? p.meta + (size_t)(l - NPAD) * 1024 : p.x + ((size_t)b * SEQ + (l - 128)) * 1024);
      ln_row_to_bf16(src, p.eg, p.eb, h0 + (size_t)t * 1024, TIDX() & 63);
    }
  }
}

template <int V> struct IC { static constexpr int value = V; };
template <int I, int N, class F> DEV void static_for(F&& f) { if constexpr (I < N) { f(IC<I>{}); static_for<I + 1, N>(f); } }
template <int MI>
DEV void gemm_core(const u16* __restrict__ A, int lda, const u16* __restrict__ Bt, int ldb, int K, int m0, int n0, char* lds, f32x16 (&acc)[MI][2]) {
  const int tid = TIDX(), lane = tid & 63, w = __builtin_amdgcn_readfirstlane(tid >> 6), r32 = lane & 31, hh = lane >> 5;
  const int wm = w >> 1, wn = w & 1;
  u16* As = (u16*)lds; u16* Bs = As + 64 * MI * 72;
#pragma unroll
  for (int i = 0; i < MI; ++i)
#pragma unroll
    for (int j = 0; j < 2; ++j)
#pragma unroll
      for (int r = 0; r < 16; ++r) acc[i][j][r] = 0.f;
  const int lrow = tid >> 3, lch = tid & 7;
  const u16* Ap = A + (size_t)(m0 + lrow) * lda + lch * 8;
  const u16* Bp = Bt + (size_t)(n0 + lrow) * ldb + lch * 8;
  u32x4 ra[2 * MI], rb[4];
#pragma unroll
  for (int i = 0; i < 2 * MI; ++i) ra[i] = *(const u32x4*)(Ap + (size_t)(32 * i) * lda);
#pragma unroll
  for (int i = 0; i < 4; ++i) rb[i] = *(const u32x4*)(Bp + (size_t)(32 * i) * ldb);
  const int nk = K / 64;
  for (int kt = 0; kt < nk; ++kt) {
    __syncthreads();
#pragma unroll
    for (int i = 0; i < 2 * MI; ++i) *(u32x4*)(As + (lrow + 32 * i) * 72 + lch * 8) = ra[i];
#pragma unroll
    for (int i = 0; i < 4; ++i) *(u32x4*)(Bs + (lrow + 32 * i) * 72 + lch * 8) = rb[i];
    __syncthreads();
    if (kt + 1 < nk) {
      const int k0 = (kt + 1) * 64;
#pragma unroll
      for (int i = 0; i < 2 * MI; ++i) ra[i] = *(const u32x4*)(Ap + (size_t)(32 * i) * lda + k0);
#pragma unroll
      for (int i = 0; i < 4; ++i) rb[i] = *(const u32x4*)(Bp + (size_t)(32 * i) * ldb + k0);
    }
#pragma unroll
    for (int ks = 0; ks < 4; ++ks) {
      bf16x8 a[MI], b[2];
#pragma unroll
      for (int i = 0; i < MI; ++i) a[i] = *(const bf16x8*)(As + (wm * 32 * MI + i * 32 + r32) * 72 + ks * 16 + hh * 8);
#pragma unroll
      for (int i = 0; i < 2; ++i) b[i] = *(const bf16x8*)(Bs + (wn * 64 + i * 32 + r32) * 72 + ks * 16 + hh * 8);
#pragma unroll
      for (int i = 0; i < MI; ++i)
#pragma unroll
        for (int j = 0; j < 2; ++j) acc[i][j] = MFMA(a[i], b[j], acc[i][j]);
    }
  }
}
template <int MI, class Epi>
DEV void gemm_direct_epi(f32x16 (&acc)[MI][2], int m0, int n0, Epi epi) {
  const int tid = TIDX(), lane = tid & 63, w = __builtin_amdgcn_readfirstlane(tid >> 6), r32 = lane & 31, hh = lane >> 5;
  const int wm = w >> 1, wn = w & 1;
  static_for<0, MI * 8>([&](auto idx) __attribute__((always_inline)) {
    constexpr int e = decltype(idx)::value; constexpr int i = e >> 3, j = (e >> 2) & 1, g = e & 3;
    const int row = m0 + wm * 32 * MI + i * 32 + 8 * g + 4 * hh;
    const int col = n0 + wn * 64 + j * 32 + r32;
    epi(row, col, acc[i][j][4 * g], acc[i][j][4 * g + 1], acc[i][j][4 * g + 2], acc[i][j][4 * g + 3]);
  });
}
template <int MI, class Epi>
DEV void gemm_tile(const u16* __restrict__ A, int lda, const u16* __restrict__ Bt, int ldb, int K, int m0, int n0, char* lds, Epi epi) {
  f32x16 acc[MI][2];
  gemm_core<MI>(A, lda, Bt, ldb, K, m0, n0, lds, acc);
  gemm_direct_epi<MI>(acc, m0, n0, epi);
}
DEV void gemm_stagedT_epi(f32x16 (&acc)[4][2], int m0, int c0, char* lds, u16* __restrict__ dst) {
  const int tid = TIDX(), lane = tid & 63, w = __builtin_amdgcn_readfirstlane(tid >> 6), r32 = lane & 31, hh = lane >> 5;
  const int wm = w >> 1, wn = w & 1;
  u16* Cs = (u16*)lds;
#pragma unroll 1
  for (int half = 0; half < 2; ++half) {
    __syncthreads();
    if (wn == half) {
      static_for<0, 32>([&](auto idx) __attribute__((always_inline)) {
        constexpr int e = decltype(idx)::value; constexpr int i = e >> 3, j = (e >> 2) & 1, g = e & 3;
        const int rl = wm * 128 + i * 32 + 8 * g + 4 * hh, cl = j * 32 + r32;
        *(u32x2*)(Cs + cl * 264 + rl) = u32x2{cvtpk(acc[i][j][4 * g], acc[i][j][4 * g + 1]), cvtpk(acc[i][j][4 * g + 2], acc[i][j][4 * g + 3])};
      });
    }
    __syncthreads();
#pragma unroll
    for (int q = 0; q < 8; ++q) {
      const int id = tid + 256 * q; const int cl = id >> 5, ch = id & 31;
      const int row = m0 + 8 * ch; const int b = row / L, l = row % L;
      *(u32x4*)(dst + ((size_t)(b * 512 + c0 + half * 64 + cl)) * L + l) = *(const u32x4*)(Cs + cl * 264 + 8 * ch);
    }
  }
}

DEV void phase_proj(const Params& p, char* lds) {
  const u16* h0 = (const u16*)(p.ws + OFF_H0); const u16* winT = (const u16*)(p.ws + OFF_WINT);
  u16* gq = (u16*)(p.ws + A_GQ); u16* gk = (u16*)(p.ws + A_GK); u16* gvT = (u16*)(p.ws + A_GVT); u16* gr = (u16*)(p.ws + A_GR);
  u16* fq = (u16*)(p.ws + A_FQ); u16* fk = (u16*)(p.ws + A_FK); u16* fvT = (u16*)(p.ws + A_FVT);
  float* ga = (float*)(p.ws + A_GA); float* logf = (float*)(p.ws + A_LOGF);
  const float* bfg = p.b_forget;
  const bool xa = (gridDim.x & 7) == 0;
  const int xg = blockIdx.x & 7, xq = blockIdx.x >> 3, xn = gridDim.x >> 3;
  const int ntiles = xa ? (132 * 3 + 17) : 132 * 25;
  auto epi = [&](int row, int col, float v0, float v1, float v2, float v3) __attribute__((always_inline)) {
      const int b = row / L, l = row % L;
      const float v[4] = {v0, v1, v2, v3};
      if (col < 256) {
        const int hd = col >> 6, d = col & 63; u16* dst = gq + ((size_t)(b * 4 + hd) * L + l) * 64 + d;
#pragma unroll
        for (int i = 0; i < 4; ++i) dst[i * 64] = f2bf(v[i]);
      } else if (col < 512) {
        const int c = col - 256, hd = c >> 6, d = c & 63; u16* dst = gk + ((size_t)(b * 4 + hd) * L + l) * 64 + d;
#pragma unroll
        for (int i = 0; i < 4; ++i) dst[i * 64] = (l + i >= NPAD) ? f2bf(v[i]) : (u16)0;
      } else if (col < 1024) {
        const int c = col - 512, hd = c >> 7, vd = c & 127;
        *(u32x2*)(gvT + ((size_t)(b * 4 + hd) * 128 + vd) * L + l) = u32x2{cvtpk(v0, v1), cvtpk(v2, v3)};
      } else if (col < 1536) {
        const int c = col - 1024; u16* dst = gr + (size_t)row * 512 + c;
#pragma unroll
        for (int i = 0; i < 4; ++i) dst[i * 512] = f2bf(v[i]);
      } else if (col < 2048) {
        const int c = col - 1536, h = c >> 6, d = c & 63; u16* dst = fq + ((size_t)(b * 8 + h) * L + l) * 64 + d;
#pragma unroll
        for (int i = 0; i < 4; ++i) dst[i * 64] = f2bf(v[i] * C2);
      } else if (col < 2560) {
        const int c = col - 2048, h = c >> 6, d = c & 63; u16* dst = fk + ((size_t)(b * 8 + h) * L + l) * 64 + d;
#pragma unroll
        for (int i = 0; i < 4; ++i) dst[i * 64] = f2bf(v[i]);
      } else if (col < 3072) {
        const int c = col - 2560, h = c >> 6, d = c & 63;
        *(u32x2*)(fvT + ((size_t)(b * 8 + h) * 64 + d) * L + l) = u32x2{cvtpk(v0, v1), cvtpk(v2, v3)};
      } else {
        const int c = col - 3072;
        if (c < 16) {
#pragma unroll
          for (int i = 0; i < 4; ++i) ga[(size_t)(row + i) * 16 + c] = v[i];
        } else if (c < 24) {
          const float bf_ = bfg[c - 16];
#pragma unroll
          for (int i = 0; i < 4; ++i) logf[(size_t)(row + i) * 8 + (c - 16)] = logsig(v[i] + bf_);
        }
      }
    };
  const int nfull = xa ? (ntiles / xn) * xn : ntiles, nunits = xa ? nfull + 2 * (ntiles - nfull) : ntiles;
  for (int j = xa ? xq : (int)blockIdx.x; j < nunits; j += xa ? xn : (int)gridDim.x) {
    const int t = (j < nfull) ? j : nfull + ((j - nfull) >> 1); const int half = (j < nfull) ? -1 : ((j - nfull) & 1);
    int mt, nt;
    if (!xa) { mt = t / 25; nt = t % 25; }
    else if (t < 396) { mt = t / 3; nt = xg + 8 * (t % 3); }
    else { mt = xg + 8 * (t - 396); nt = 24; if (mt >= 132) continue; }
    if (half >= 0) {
      f32x16 acc2[2][2];
      gemm_core<2>(h0, 1024, winT, 1024, 1024, mt * 256 + half * 128, nt * 128, lds, acc2);
      gemm_direct_epi<2>(acc2, mt * 256 + half * 128, nt * 128, epi);
      continue;
    }
    f32x16 acc[4][2];
    gemm_core<4>(h0, 1024, winT, 1024, 1024, mt * 256, nt * 128, lds, acc);
    if ((nt >> 2) == 1) { gemm_stagedT_epi(acc, mt * 256, (nt - 4) * 128, lds, gvT); continue; }
    if ((nt >> 2) == 5) { gemm_stagedT_epi(acc, mt * 256, (nt - 20) * 128, lds, fvT); continue; }
    gemm_direct_epi<4>(acc, mt * 256, nt * 128, epi);
  }
}

DEV float logsig_fast(float z) { return fminf(z, 0.f) - __logf(1.f + __expf(-fabsf(z))); }
DEV void gla_gates(const Params& p, int b, int hd, int n, float* G) {
  const float* ga = (const float*)(p.ws + A_GA);
  const int tid = TIDX(), d = tid & 63, qd = __builtin_amdgcn_readfirstlane(tid >> 6);
  const int cc = hd * 64 + d;
  float wv[16];
#pragma unroll
  for (int r = 0; r < 16; ++r) wv[r] = p.w_gu[r * 256 + cc];
  const float bg = p.b_gate[cc];
  const float* gap = ga + ((size_t)b * L + 64 * n + 16 * qd) * 16;
  float v[16]; float run = 0.f;
#pragma unroll
  for (int i = 0; i < 16; ++i) {
    float z = bg;
#pragma unroll
    for (int r = 0; r < 16; ++r) z = fmaf(gap[i * 16 + r], wv[r], z);
    run += logsig_fast(z) * (1.f / 16.f); v[i] = run;
  }
  float* tot = G + 64 * 65;
  tot[qd * 64 + d] = run;
  __syncthreads();
  float off = 0.f;
  for (int k = 0; k < qd; ++k) off += tot[k * 64 + d];
#pragma unroll
  for (int i = 0; i < 16; ++i) G[(16 * qd + i) * 65 + d] = v[i] + off;
  __syncthreads();
}

DEV void gla_g1_item(const Params& p, int b, int hd, int n, char* lds) {
  float* G = (float*)lds;
  u16* KT = (u16*)(lds + 16640);
  const u16* gk = (const u16*)(p.ws + A_GK); const u16* gvT = (const u16*)(p.ws + A_GVT);
  float* st = (float*)(p.ws + OFF_ST); float* dec = (float*)(p.ws + A_DEC);
  const int tid = TIDX(), lane = tid & 63, w = __builtin_amdgcn_readfirstlane(tid >> 6), r32 = lane & 31, hh = lane >> 5;
  const int bh = b * 4 + hd;
  gla_gates(p, b, hd, n, G);
  {
    const int c = tid >> 2, dq = tid & 3;
    const u16* kr = gk + ((size_t)bh * L + 64 * n + c) * 64 + 16 * dq;
    const u32x4 k0 = *(const u32x4*)kr, k1 = *(const u32x4*)(kr + 8);
    const unsigned kk[8] = {k0[0], k0[1], k0[2], k0[3], k1[0], k1[1], k1[2], k1[3]};
#pragma unroll
    for (int j = 0; j < 16; ++j) {
      const int d = 16 * dq + j;
      const float kv = (j & 1) ? bfhi(kk[j >> 1]) : bflo(kk[j >> 1]);
      KT[d * 72 + c] = f2bf(kv * __expf(G[63 * 65 + d] - G[c * 65 + d]));
    }
    if (tid < 64) dec[((size_t)bh * NCH + n) * 64 + tid] = __expf(G[63 * 65 + tid]);
  }
  __syncthreads();
  f32x16 acc[2];
#pragma unroll
  for (int r = 0; r < 16; ++r) { acc[0][r] = 0.f; acc[1][r] = 0.f; }
  const u16* vrow = gvT + ((size_t)bh * 128 + 32 * w + r32) * L + 64 * n + 8 * hh;
#pragma unroll
  for (int ks = 0; ks < 4; ++ks) {
    const bf16x8 a = *(const bf16x8*)(vrow + 16 * ks);
#pragma unroll
    for (int dt = 0; dt < 2; ++dt) {
      const bf16x8 bb = *(const bf16x8*)(KT + (32 * dt + r32) * 72 + 16 * ks + 8 * hh);
      acc[dt] = MFMA(a, bb, acc[dt]);
    }
  }
  float* so = st + ((size_t)bh * NCH + n) * 128 * 64;
#pragma unroll
  for (int dt = 0; dt < 2; ++dt)
#pragma unroll
    for (int r = 0; r < 16; ++r) so[(size_t)(32 * w + crow(r, hh)) * 64 + 32 * dt + r32] = acc[dt][r];
  __syncthreads();
}

DEV void split3(float x, u16& a, u16& b, u16& c) {
  a = f2bf(x); float r = x - bf2f(a); b = f2bf(r); r -= bf2f(b); c = f2bf(r);
}
DEV void fox_cscan(const Params& p, int bh) {
  const float* logf = (const float*)(p.ws + A_LOGF);
  u16* qaug = (u16*)(p.ws + A_QAUG); u16* kaug = (u16*)(p.ws + A_KAUG);
  const int lane = TIDX() & 63; const int b = bh >> 3, h = bh & 7;
  float carry = 0.f;
  float lv[L / 64];
#pragma unroll
  for (int i = 0; i < L / 64; ++i) lv[i] = logf[((size_t)b * L + 64 * i + lane) * 8 + h];
#pragma unroll
  for (int i = 0; i < L / 64; ++i) {
    const int l = 64 * i + lane;
    float v = lv[i];
#pragma unroll
    for (int o = 1; o < 64; o <<= 1) { const float u = __shfl_up(v, o); if (lane >= o) v += u; }
    const float c = (carry + v) * LOG2E;
    carry += __shfl(v, 63);
    ((float*)(p.ws + A_C2))[(size_t)bh * L + l] = c;
    u16 a0, a1, a2, n0, n1, n2;
    split3(c, a0, a1, a2); split3(-c, n0, n1, n2);
    const u16 one = 0x3f80;
    u16* qa = qaug + ((size_t)bh * L + l) * 16; u16* ka = kaug + ((size_t)bh * L + l) * 16;
    *(u32x4*)qa = u32x4{(unsigned)one | ((unsigned)one << 16), (unsigned)one | ((unsigned)a0 << 16), (unsigned)a1 | ((unsigned)a2 << 16), 0u};
    *(u32x4*)(qa + 8) = u32x4{0u, 0u, 0u, 0u};
    *(u32x4*)ka = u32x4{(unsigned)n0 | ((unsigned)n1 << 16), (unsigned)n2 | ((unsigned)one << 16), (unsigned)one | ((unsigned)one << 16), 0u};
    *(u32x4*)(ka + 8) = u32x4{0u, 0u, 0u, 0u};
  }
}
DEV void fox_norms(const Params& p, int wi) {
  const int bh = wi / NCH, l = (wi % NCH) * 64 + (TIDX() & 63);
  const u16* fq = (const u16*)(p.ws + A_FQ) + ((size_t)bh * L + l) * 64; const u16* fk = (const u16*)(p.ws + A_FK) + ((size_t)bh * L + l) * 64;
  float sq = 0.f, sk = 0.f;
#pragma unroll
  for (int i = 0; i < 8; ++i) {
    const u32x4 a = *(const u32x4*)(fq + 8 * i), b = *(const u32x4*)(fk + 8 * i);
#pragma unroll
    for (int j = 0; j < 4; ++j) { sq += bflo(a[j]) * bflo(a[j]) + bfhi(a[j]) * bfhi(a[j]); sk += bflo(b[j]) * bflo(b[j]) + bfhi(b[j]) * bfhi(b[j]); }
  }
#pragma unroll
  for (int o = 32; o > 0; o >>= 1) { sq = fmaxf(sq, __shfl_xor(sq, o)); sk = fmaxf(sk, __shfl_xor(sk, o)); }
  if ((TIDX() & 63) == 0) {
    unsigned* bar = (unsigned*)(p.ws + OFF_BAR);
    atomicMax(bar + BAR_QN + bh, __float_as_uint(sq)); atomicMax(bar + BAR_KN + bh, __float_as_uint(sk));
  }
}
DEV int next_item(unsigned* ctr, volatile int* slot);
DEV void phase_g1(const Params& p, char* lds) {
  const int n_g1 = NB * 4 * NCH, n_cs = 16, n_nm = 64 * NCH / 4;
  unsigned* ctr = (unsigned*)(p.ws + OFF_BAR) + BAR_WQ + 2; volatile int* slot = (volatile int*)(lds + 55296);
#pragma unroll 1
  for (int it = next_item(ctr, slot); it < n_g1 + n_cs + n_nm; it = next_item(ctr, slot)) {
    if (it < n_cs) fox_cscan(p, it * 4 + __builtin_amdgcn_readfirstlane(TIDX() >> 6));
    else if (it < n_cs + n_g1) { const int i = it - n_cs; const int bh = i / NCH, n = i % NCH; gla_g1_item(p, bh >> 2, bh & 3, n, lds); }
    else fox_norms(p, (it - n_cs - n_g1) * 4 + __builtin_amdgcn_readfirstlane(TIDX() >> 6));
  }
}

DEV void quant_rows(const Params& p, int wi, int lane);
DEV void phase_scan(const Params& p) {
  float* st = (float*)(p.ws + OFF_ST); const float* dec = (const float*)(p.ws + A_DEC);
  const int n_sc = NB * 4 * 8192 / 512, n_qt = 16384 / 4;
  for (int it = blockIdx.x; it < n_sc + n_qt; it += gridDim.x) {
    if (it >= n_sc) { const int tid = TIDX(); quant_rows(p, (it - n_sc) * 4 + __builtin_amdgcn_readfirstlane(tid >> 6), tid & 63); continue; }
    const int e = it * 512 + TIDX(); const int bh = e >> 13, r = e & 8191, d = r & 63;
    float* sp = st + (size_t)bh * NCH * 8192 + r; const float* dp = dec + (size_t)bh * NCH * 64 + d;
    float S0 = 0.f, S1 = 0.f;
#pragma unroll 1
    for (int n0 = 0; n0 < NCH; n0 += 11) {
      float d0[11], d1[11], dc[11];
#pragma unroll
      for (int j = 0; j < 11; ++j) { d0[j] = sp[(size_t)(n0 + j) * 8192]; d1[j] = sp[(size_t)(n0 + j) * 8192 + 256]; dc[j] = dp[(n0 + j) * 64]; }
#pragma unroll
      for (int j = 0; j < 11; ++j) { const float o0 = S0, o1 = S1; S0 = dc[j] * S0 + d0[j]; S1 = dc[j] * S1 + d1[j]; d0[j] = o0; d1[j] = o1; }
#pragma unroll
      for (int j = 0; j < 11; ++j) { sp[(size_t)(n0 + j) * 8192] = d0[j]; sp[(size_t)(n0 + j) * 8192 + 256] = d1[j]; }
    }
  }
}

DEV void gla_g3_item(const Params& p, int b, int hd, int n, char* lds) {
  float* G = (float*)lds;
  u16* QI = (u16*)(lds + 16640); u16* KI = QI + 64 * 72; u16* QD = KI + 64 * 72;
  float* part = (float*)(lds + 16640 + 3 * 9216);
  const u16* gq = (const u16*)(p.ws + A_GQ); const u16* gk = (const u16*)(p.ws + A_GK); const u16* gvT = (const u16*)(p.ws + A_GVT);
  const u16* gr = (const u16*)(p.ws + A_GR); const float* st = (const float*)(p.ws + OFF_ST); u16* o = (u16*)(p.ws + OFF_O);
  const int tid = TIDX(), lane = tid & 63, w = __builtin_amdgcn_readfirstlane(tid >> 6), r32 = lane & 31, hh = lane >> 5;
  const int bh = b * 4 + hd;
  gla_gates(p, b, hd, n, G);
  {
    const int c = tid >> 2, dq = tid & 3;
    const size_t ro = ((size_t)bh * L + 64 * n + c) * 64 + 16 * dq;
    const u32x4 q0 = *(const u32x4*)(gq + ro), q1 = *(const u32x4*)(gq + ro + 8), k0 = *(const u32x4*)(gk + ro), k1 = *(const u32x4*)(gk + ro + 8);
    const unsigned qq[8] = {q0[0], q0[1], q0[2], q0[3], q1[0], q1[1], q1[2], q1[3]};
    const unsigned kk[8] = {k0[0], k0[1], k0[2], k0[3], k1[0], k1[1], k1[2], k1[3]};
    unsigned oqi[8], oki[8], oqd[8];
#pragma unroll
    for (int j2 = 0; j2 < 8; ++j2) {
      float qi[2], ki[2], qd[2];
#pragma unroll
      for (int e = 0; e < 2; ++e) {
        const int d = 16 * dq + 2 * j2 + e;
        const float qv = e ? bfhi(qq[j2]) : bflo(qq[j2]); const float kv = e ? bfhi(kk[j2]) : bflo(kk[j2]);
        const float bc = G[c * 65 + d], br = G[31 * 65 + d];
        qi[e] = qv * __expf(bc - br) * 0.125f; ki[e] = kv * __expf(br - bc); qd[e] = qv * __expf(bc) * 0.125f;
      }
      oqi[j2] = cvtpk(qi[0], qi[1]); oki[j2] = cvtpk(ki[0], ki[1]); oqd[j2] = cvtpk(qd[0], qd[1]);
    }
    *(u32x4*)(QI + c * 72 + 16 * dq) = u32x4{oqi[0], oqi[1], oqi[2], oqi[3]}; *(u32x4*)(QI + c * 72 + 16 * dq + 8) = u32x4{oqi[4], oqi[5], oqi[6], oqi[7]};
    *(u32x4*)(KI + c * 72 + 16 * dq) = u32x4{oki[0], oki[1], oki[2], oki[3]}; *(u32x4*)(KI + c * 72 + 16 * dq + 8) = u32x4{oki[4], oki[5], oki[6], oki[7]};
    *(u32x4*)(QD + c * 72 + 16 * dq) = u32x4{oqd[0], oqd[1], oqd[2], oqd[3]}; *(u32x4*)(QD + c * 72 + 16 * dq + 8) = u32x4{oqd[4], oqd[5], oqd[6], oqd[7]};
  }
  __syncthreads();
  f32x16 at[2][2];
#pragma unroll
  for (int i = 0; i < 2; ++i)
#pragma unroll
    for (int j = 0; j < 2; ++j)
#pragma unroll
      for (int r = 0; r < 16; ++r) at[i][j][r] = 0.f;
#pragma unroll
  for (int ks = 0; ks < 4; ++ks) {
    bf16x8 ka[2], qb[2];
#pragma unroll
    for (int i = 0; i < 2; ++i) { ka[i] = *(const bf16x8*)(KI + (32 * i + r32) * 72 + 16 * ks + 8 * hh); qb[i] = *(const bf16x8*)(QI + (32 * i + r32) * 72 + 16 * ks + 8 * hh); }
#pragma unroll
    for (int i = 0; i < 2; ++i)
#pragma unroll
      for (int j = 0; j < 2; ++j) at[i][j] = MFMA(ka[i], qb[j], at[i][j]);
  }
  unsigned pw[2][2][8];
#pragma unroll
  for (int stt = 0; stt < 2; ++stt)
#pragma unroll
    for (int ct = 0; ct < 2; ++ct)
#pragma unroll
      for (int r2 = 0; r2 < 8; ++r2) {
        const int s0 = 32 * stt + crow(2 * r2, hh), cc = 32 * ct + r32;
        const float v0 = (s0 <= cc) ? at[stt][ct][2 * r2] : 0.f, v1 = (s0 + 1 <= cc) ? at[stt][ct][2 * r2 + 1] : 0.f;
        pw[stt][ct][r2] = cvtpk(v0, v1);
      }
  f32x16 oa[2];
#pragma unroll
  for (int r = 0; r < 16; ++r) { oa[0][r] = 0.f; oa[1][r] = 0.f; }
  const u16* vrow = gvT + ((size_t)bh * 128 + 32 * w + r32) * L + 64 * n;
#pragma unroll
  for (int stt = 0; stt < 2; ++stt)
#pragma unroll
    for (int s2 = 0; s2 < 2; ++s2) {
      const u32x2 lo = *(const u32x2*)(vrow + 32 * stt + 16 * s2 + 4 * hh), hi = *(const u32x2*)(vrow + 32 * stt + 16 * s2 + 8 + 4 * hh);
      const bf16x8 vf = asbf(u32x4{lo[0], lo[1], hi[0], hi[1]});
#pragma unroll
      for (int ct = 0; ct < 2; ++ct) {
        const bf16x8 pf = asbf(u32x4{pw[stt][ct][4 * s2], pw[stt][ct][4 * s2 + 1], pw[stt][ct][4 * s2 + 2], pw[stt][ct][4 * s2 + 3]});
        oa[ct] = MFMA(vf, pf, oa[ct]);
      }
    }
  const float* srow = st + (((size_t)bh * NCH + n) * 128 + 32 * w + r32) * 64 + 8 * hh;
#pragma unroll
  for (int ks = 0; ks < 4; ++ks) {
    const f32x4 s0 = *(const f32x4*)(srow + 16 * ks), s1 = *(const f32x4*)(srow + 16 * ks + 4);
    const bf16x8 sf = asbf(u32x4{cvtpk(s0[0], s0[1]), cvtpk(s0[2], s0[3]), cvtpk(s1[0], s1[1]), cvtpk(s1[2], s1[3])});
#pragma unroll
    for (int ct = 0; ct < 2; ++ct) {
      const bf16x8 qf = *(const bf16x8*)(QD + (32 * ct + r32) * 72 + 16 * ks + 8 * hh);
      oa[ct] = MFMA(sf, qf, oa[ct]);
    }
  }
#pragma unroll
  for (int ct = 0; ct < 2; ++ct) { float s = 0.f;
#pragma unroll
    for (int r = 0; r < 16; ++r) s += oa[ct][r] * oa[ct][r];
    part[(2 * w + hh) * 64 + 32 * ct + r32] = s; }
  __syncthreads();
#pragma unroll
  for (int ct = 0; ct < 2; ++ct) {
    const int c = 32 * ct + r32; float tot = 0.f;
#pragma unroll
    for (int i = 0; i < 8; ++i) tot += part[i * 64 + c];
    const float rn = rsqrtf(tot * (1.f / 128.f) + LN_EPS);
    const size_t t = (size_t)b * L + 64 * n + c;
#pragma unroll
    for (int g = 0; g < 4; ++g) {
      const int vd = 32 * w + 8 * g + 4 * hh; const int cc = hd * 128 + vd;
      const u32x2 rr = *(const u32x2*)(gr + t * 512 + cc);
      const float rv[4] = {bflo(rr[0]), bfhi(rr[0]), bflo(rr[1]), bfhi(rr[1])};
      float ov[4];
#pragma unroll
      for (int i = 0; i < 4; ++i) { const float sl = rv[i] / (1.f + __expf(-rv[i])); ov[i] = oa[ct][4 * g + i] * rn * p.gng[cc + i] * sl; }
      *(u32x2*)(o + t * 1024 + cc) = u32x2{cvtpk(ov[0], ov[1]), cvtpk(ov[2], ov[3])};
    }
  }
  __syncthreads();
}

DEV void fox_attn_item(const Params& p, int b, int h, int qb, char* lds) {
  u16* Ks = (u16*)lds;
  u16* Ka = Ks + 64 * 72;
  u16* Vs = Ka + 64 * 24;
  const int tid = TIDX(), lane = tid & 63, w = __builtin_amdgcn_readfirstlane(tid >> 6), r32 = lane & 31, hh = lane >> 5;
  const size_t bh = (size_t)b * 8 + h;
  const u16* fq = (const u16*)(p.ws + A_FQ) + bh * L * 64; const u16* fk = (const u16*)(p.ws + A_FK) + bh * L * 64;
  const u16* fvT = (const u16*)(p.ws + A_FVT) + bh * 64 * L;
  const u16* qaug = (const u16*)(p.ws + A_QAUG) + bh * L * 16; const u16* kaug = (const u16*)(p.ws + A_KAUG) + bh * L * 16;
  u16* o = (u16*)(p.ws + OFF_O);
  const int ql = 128 * qb + 32 * w + r32;
  bf16x8 qf[5];
#pragma unroll
  for (int d0 = 0; d0 < 4; ++d0) qf[d0] = *(const bf16x8*)(fq + (size_t)ql * 64 + 16 * d0 + 8 * hh);
  qf[4] = *(const bf16x8*)(qaug + (size_t)ql * 16 + 8 * hh);
  f32x16 o0, o1;
#pragma unroll
  for (int r = 0; r < 16; ++r) { o0[r] = 0.f; o1[r] = 0.f; }
  float m = -1e30f, lsum = 0.f;
  const int wqmin = 128 * qb + 32 * w, wqmax = wqmin + 31;
  const int kt_hi = 2 * qb + 1, kt_lo = 1;
  u32x4 rk[2], rv[2], rka;
  const int krow = tid >> 3, kch = tid & 7;
  volatile int* doneflag = (volatile int*)(lds + 55296 + 16);
  const float* c2p = (const float*)(p.ws + A_C2) + bh * L;
  const unsigned* bar = (const unsigned*)(p.ws + OFF_BAR);
  const float U = sqrtf(__uint_as_float(bar[BAR_QN + bh]) * __uint_as_float(bar[BAR_KN + bh]));
  const float cqb = c2p[128 * qb];
  int mydone = 0;
  auto gload = [&](int kt) {
#pragma unroll
    for (int i = 0; i < 2; ++i) {
      rk[i] = *(const u32x4*)(fk + (size_t)(64 * kt + krow + 32 * i) * 64 + 8 * kch);
      rv[i] = *(const u32x4*)(fvT + (size_t)(krow + 32 * i) * L + 64 * kt + 8 * kch);
    }
    if (tid < 128) rka = *(const u32x4*)(kaug + (size_t)(64 * kt + (tid >> 1)) * 16 + 8 * (tid & 1));
  };
  gload(kt_hi);
  for (int kt = kt_hi; kt >= kt_lo; --kt) {
    if (!mydone && kt < 2 * qb) {
      float mm = m;
#pragma unroll
      for (int o = 16; o > 0; o >>= 1) mm = fminf(mm, __shfl_xor(mm, o));
      if (cqb - c2p[64 * kt + 63] + U < mm - 40.f) mydone = 1;
    }
    if (lane == 0) doneflag[w] = mydone;
    __syncthreads();
    if (doneflag[0] + doneflag[1] + doneflag[2] + doneflag[3] == 4) break;
#pragma unroll
    for (int i = 0; i < 2; ++i) {
      *(u32x4*)(Ks + (krow + 32 * i) * 72 + 8 * kch) = rk[i];
      u16* vd = Vs + (krow + 32 * i) * 68 + 8 * kch;
      *(u32x2*)vd = u32x2{rv[i][0], rv[i][1]}; *(u32x2*)(vd + 4) = u32x2{rv[i][2], rv[i][3]};
    }
    if (tid < 128) { u16* kd = Ka + (tid >> 1) * 24 + 8 * (tid & 1); *(u32x4*)kd = rka; }
    __syncthreads();
    if (kt > kt_lo) gload(kt - 1);
    if (64 * kt <= wqmax && !mydone) {
      f32x16 s0, s1;
#pragma unroll
      for (int r = 0; r < 16; ++r) { s0[r] = 0.f; s1[r] = 0.f; }
#pragma unroll
      for (int d0 = 0; d0 < 4; ++d0) {
        const bf16x8 k0 = *(const bf16x8*)(Ks + r32 * 72 + 16 * d0 + 8 * hh), k1 = *(const bf16x8*)(Ks + (32 + r32) * 72 + 16 * d0 + 8 * hh);
        s0 = MFMA(k0, qf[d0], s0); s1 = MFMA(k1, qf[d0], s1);
      }
      {
        const bf16x8 k0 = *(const bf16x8*)(Ka + r32 * 24 + 8 * hh), k1 = *(const bf16x8*)(Ka + (32 + r32) * 24 + 8 * hh);
        s0 = MFMA(k0, qf[4], s0); s1 = MFMA(k1, qf[4], s1);
      }
      if (kt == 1 || 64 * kt + 63 > wqmin) {
#pragma unroll
        for (int r = 0; r < 16; ++r) {
          const int k0 = 64 * kt + crow(r, hh), k1 = k0 + 32;
          if (!(k0 <= ql && k0 >= NPAD)) s0[r] = -1e30f;
          if (!(k1 <= ql && k1 >= NPAD)) s1[r] = -1e30f;
        }
      }
      float rm = fmaxf(s0[0], s1[0]);
#pragma unroll
      for (int r = 1; r < 16; ++r) rm = fmaxf(rm, fmaxf(s0[r], s1[r]));
      rm = fmaxf(rm, __shfl_xor(rm, 32));
      const float mn = fmaxf(m, rm); const float alpha = __builtin_amdgcn_exp2f(m - mn); m = mn;
      float ps = 0.f;
#pragma unroll
      for (int r = 0; r < 16; ++r) { s0[r] = __builtin_amdgcn_exp2f(s0[r] - mn); s1[r] = __builtin_amdgcn_exp2f(s1[r] - mn); ps += s0[r] + s1[r]; }
      lsum = lsum * alpha + ps;
#pragma unroll
      for (int r = 0; r < 16; ++r) { o0[r] *= alpha; o1[r] *= alpha; }
      unsigned pw0[8], pw1[8];
#pragma unroll
      for (int i = 0; i < 8; ++i) { pw0[i] = cvtpk(s0[2 * i], s0[2 * i + 1]); pw1[i] = cvtpk(s1[2 * i], s1[2 * i + 1]); }
#pragma unroll
      for (int nk = 0; nk < 2; ++nk)
#pragma unroll
        for (int s2 = 0; s2 < 2; ++s2) {
          const bf16x8 pf = nk ? asbf(u32x4{pw1[4 * s2], pw1[4 * s2 + 1], pw1[4 * s2 + 2], pw1[4 * s2 + 3]}) : asbf(u32x4{pw0[4 * s2], pw0[4 * s2 + 1], pw0[4 * s2 + 2], pw0[4 * s2 + 3]});
          {
            const u16* vb = Vs + r32 * 68 + 32 * nk + 16 * s2 + 4 * hh;
            const u32x2 lo = *(const u32x2*)vb, hi = *(const u32x2*)(vb + 8);
            o0 = MFMA(asbf(u32x4{lo[0], lo[1], hi[0], hi[1]}), pf, o0);
          }
          {
            const u16* vb = Vs + (32 + r32) * 68 + 32 * nk + 16 * s2 + 4 * hh;
            const u32x2 lo = *(const u32x2*)vb, hi = *(const u32x2*)(vb + 8);
            o1 = MFMA(asbf(u32x4{lo[0], lo[1], hi[0], hi[1]}), pf, o1);
          }
        }
    }
  }
  const float ltot = lsum + __shfl_xor(lsum, 32); const float inv = 1.f / ltot;
  float ssq = 0.f;
#pragma unroll
  for (int r = 0; r < 16; ++r) { o0[r] *= inv; o1[r] *= inv; ssq += o0[r] * o0[r] + o1[r] * o1[r]; }
  ssq += __shfl_xor(ssq, 32);
  const float rn = rsqrtf(ssq * (1.f / 64.f) + LN_EPS);
  const size_t t = (size_t)b * L + ql;
#pragma unroll
  for (int dt = 0; dt < 2; ++dt)
#pragma unroll
    for (int g = 0; g < 4; ++g) {
      const int d = 32 * dt + 8 * g + 4 * hh; const int cc = h * 64 + d;
      float ov[4];
#pragma unroll
      for (int i = 0; i < 4; ++i) ov[i] = (dt ? o1[4 * g + i] : o0[4 * g + i]) * rn * p.fng[cc + i];
      *(u32x2*)(o + t * 1024 + 512 + cc) = u32x2{cvtpk(ov[0], ov[1]), cvtpk(ov[2], ov[3])};
    }
  __syncthreads();
}
DEV int next_item(unsigned* ctr, volatile int* slot) {
  __syncthreads();
  if (TIDX() == 0) *slot = (int)atomicAdd(ctr, 1u);
  __syncthreads();
  return *slot;
}
DEV void phase_mix(const Params& p0, char* lds) {
  const int n_at = NB * 8 * 32, n_g3 = NB * 4 * 64;
  volatile int* slot = (volatile int*)(lds + 55296);
  {
    Params p = p0; { size_t z = 0; asm volatile("" : "+s"(z) :: "memory"); p.ws = p0.ws + z; }
    unsigned* ctr = (unsigned*)(p.ws + OFF_BAR) + BAR_WQ;
#pragma unroll 1
    for (int it = next_item(ctr, slot); it < n_at; it = next_item(ctr, slot)) { const int qb = 32 - (it >> 6), bh = it & 63; fox_attn_item(p, bh >> 3, bh & 7, qb, lds); }
  }
  {
    Params p = p0; { size_t z = 0; asm volatile("" : "+s"(z) :: "memory"); p.ws = p0.ws + z; }
    unsigned* ctr = (unsigned*)(p.ws + OFF_BAR) + BAR_WQ + 1;
#pragma unroll 1
    for (int i = next_item(ctr, slot); i < n_g3; i = next_item(ctr, slot)) { const int bh = i >> 6, n = 2 + (i & 63); gla_g3_item(p, bh >> 2, bh & 3, n, lds); }
  }
}

DEV int real_mtile(int i) { return (i >> 5) * 33 + 1 + (i & 31); }
DEV int real_m0(int i) { return (i >> 4) * L + 128 + (i & 15) * 256; }
DEV void phase_outproj(const Params& p, char* lds) {
  const u16* o = (const u16*)(p.ws + OFF_O); const u16* woutT = (const u16*)(p.ws + OFF_WOUTT); const u16* h0 = (const u16*)(p.ws + OFF_H0);
  float* pre1 = (float*)(p.ws + OFF_A);
  for (int tile = blockIdx.x; tile < 128 * 8; tile += gridDim.x) {
    const int m0 = real_m0(tile >> 3), nt = tile & 7;
    gemm_tile<4>(o, 1024, woutT, 1024, 1024, m0, nt * 128, lds, [&](int row, int col, float v0, float v1, float v2, float v3) __attribute__((always_inline)) {
      const float v[4] = {v0, v1, v2, v3};
#pragma unroll
      for (int i = 0; i < 4; ++i) { const size_t e = (size_t)(row + i) * 1024 + col; pre1[e] = DN_ALPHA * bf2f(h0[e]) + v[i]; }
    });
  }
}

DEV void quant_rows(const Params& p, int wi, int lane) {
  unsigned char* tq = (unsigned char*)(p.ws + OFF_TBL); float* tsc = (float*)(p.ws + OFF_TBL + TBL_SC);
  const int r = 2 * wi + (lane >> 5); const int c = lane & 31;
  const float* src = ((r < 16384) ? p.pu + (size_t)r * 1024 : p.pv + (size_t)(r - 16384) * 1024) + 32 * c;
  v16f a, b;
#pragma unroll
  for (int i = 0; i < 4; ++i) {
    const f32x4 x0 = *(const f32x4*)(src + 4 * i), x1 = *(const f32x4*)(src + 16 + 4 * i);
#pragma unroll
    for (int j = 0; j < 4; ++j) { a[4 * i + j] = x0[j]; b[4 * i + j] = x1[j]; }
  }
  float am = 0.f;
#pragma unroll
  for (int i = 0; i < 16; ++i) am = fmaxf(am, fmaxf(fabsf(a[i]), fabsf(b[i])));
#pragma unroll
  for (int o = 16; o > 0; o >>= 1) am = fmaxf(am, __shfl_xor(am, o));
  const float sc = (am > 0.f) ? am * (1.f / 7.5f) : 1.f; const float isc = 1.f / sc;
#pragma unroll
  for (int i = 0; i < 16; ++i) { a[i] *= isc; b[i] *= isc; }
  {
    const float k4 = 6.f / 7.5f;
    unsigned p4[4] = {0u, 0u, 0u, 0u};
    static_for<0, 32>([&](auto ix) __attribute__((always_inline)) {
      constexpr int i = decltype(ix)::value;
      const float v = ((i < 16) ? a[i & 15] : b[i & 15]) * k4;
      const float av = fabsf(v);
      const unsigned code = (unsigned)(av > 0.25f) + (unsigned)(av > 0.75f) + (unsigned)(av > 1.25f) + (unsigned)(av > 1.75f) + (unsigned)(av > 2.5f) + (unsigned)(av > 3.5f) + (unsigned)(av > 5.f);
      p4[i >> 3] |= (code | ((v < 0.f) ? 8u : 0u)) << (4 * (i & 7));
    });
    *(u32x4*)(tq + (size_t)r * 512 + 16 * c) = u32x4{p4[0], p4[1], p4[2], p4[3]};
    if (c == 0) tsc[r] = sc * (7.5f / 6.f);
    return;
  }
  unsigned pk[6] = {0u, 0u, 0u, 0u, 0u, 0u};
  static_for<0, 32>([&](auto ix) __attribute__((always_inline)) {
    constexpr int i = decltype(ix)::value;
    const float v = (i < 16) ? a[i & 15] : b[i & 15];
    const float av = fabsf(v);
    float cf = (av < 2.f) ? av * 8.f : ((av < 4.f) ? 16.f + (av - 2.f) * 4.f : 24.f + (av - 4.f) * 2.f);
    unsigned code = (unsigned)(int)rintf(cf); code = code > 31u ? 31u : code;
    const unsigned f = code | ((v < 0.f) ? 32u : 0u);
    constexpr int bp = 6 * i, di = bp >> 5, off = bp & 31;
    pk[di] |= f << off;
    if constexpr (off > 26) pk[di + 1] |= f >> (32 - off);
  });
  u32x2* dst = (u32x2*)(tq + TBL_V + (size_t)(r - 16384) * 768 + 24 * c);
  dst[0] = u32x2{pk[0], pk[1]}; dst[1] = u32x2{pk[2], pk[3]}; dst[2] = u32x2{pk[4], pk[5]};
  if (c == 0) tsc[r] = sc;
}
DEV void phase_ln1(const Params& p) {
  const float* pre1 = (const float*)(p.ws + OFF_A); u16* h1 = (u16*)(p.ws + OFF_ST);
  const int tid = TIDX(); const int lane = tid & 63, wv = __builtin_amdgcn_readfirstlane(tid >> 6);
  for (int it = blockIdx.x; it < 32768 / 4; it += gridDim.x) {
    const int ti = it * 4 + wv; const int t = (ti >> 12) * L + 128 + (ti & 4095);
    ln_row_to_bf16(pre1 + (size_t)t * 1024, p.ln1g, p.ln1b, h1 + (size_t)t * 1024, lane);
  }
}

DEV void phase_peerq(const Params& p, char* lds) {
  const u16* h1 = (const u16*)(p.ws + OFF_ST); const u16* wqT = (const u16*)(p.ws + OFF_WQT); u16* qp = (u16*)(p.ws + OFF_A);
  const bool xa = (gridDim.x & 7) == 0;
  for (int tile = blockIdx.x; tile < 128 * 16; tile += gridDim.x) {
    const int mt_ = xa ? (tile >> 4) : (tile >> 4), nt = xa ? ((tile & 7) + 8 * ((tile >> 3) & 1)) : (tile & 15);
    const int m0 = real_m0(mt_);
    gemm_tile<4>(h1, 1024, wqT, 1024, 1024, m0, nt * 128, lds, [&](int row, int col, float v0, float v1, float v2, float v3) __attribute__((always_inline)) {
      u16* dst = qp + (size_t)row * 2048 + col;
      dst[0] = f2bf(v0); dst[2048] = f2bf(v1); dst[4096] = f2bf(v2); dst[6144] = f2bf(v3);
    });
  }
}

DEV unsigned fkey(float f) { const unsigned u = __float_as_uint(f); return (u & 0x80000000u) ? ~u : (u | 0x80000000u); }
DEV float kval(unsigned k) { const unsigned u = (k & 0x80000000u) ? (k & 0x7fffffffu) : ~k; return __uint_as_float(u); }
DEV void ins16(unsigned (&Lst)[16], unsigned x) {
#pragma unroll
  for (int i = 0; i < 16; ++i) { const unsigned hi = max(Lst[i], x); x = min(Lst[i], x); Lst[i] = hi; }
}
DEV void cswap_desc(unsigned& a, unsigned& b) { const unsigned hi = max(a, b), lo = min(a, b); a = hi; b = lo; }
template <int K, int J> DEV void bstage(unsigned (&a)[16]) {
  static_for<0, 16>([&](auto ix) __attribute__((always_inline)) {
    constexpr int i = decltype(ix)::value; constexpr int l = i ^ J;
    if constexpr (l > i) {
      const unsigned hi = max(a[i], a[l]), lo = min(a[i], a[l]);
      if constexpr ((i & K) == 0) { a[i] = hi; a[l] = lo; } else { a[i] = lo; a[l] = hi; }
    }
  });
}
DEV void sort16_desc(unsigned (&a)[16]) {
  bstage<2, 1>(a); bstage<4, 2>(a); bstage<4, 1>(a); bstage<8, 4>(a); bstage<8, 2>(a); bstage<8, 1>(a);
  bstage<16, 8>(a); bstage<16, 4>(a); bstage<16, 2>(a); bstage<16, 1>(a);
}
DEV void merge16_desc(unsigned (&a)[16], const unsigned (&b)[16]) {
#pragma unroll
  for (int i = 0; i < 16; ++i) a[i] = max(a[i], b[15 - i]);
  bstage<16, 8>(a); bstage<16, 4>(a); bstage<16, 2>(a); bstage<16, 1>(a);
}
constexpr int C1I[16] = {1, 1, 1, 1, 1, 1, 1, 1, 2, 2, 2, 2, 2, 4, 4, 4}, C1J[16] = {0, 1, 2, 3, 4, 5, 6, 7, 0, 1, 2, 3, 4, 0, 1, 2};
constexpr int C2I[16] = {3, 3, 3, 3, 5, 5, 6, 6, 7, 7, 8, 9, 10, 11, 12, 13}, C2J[16] = {0, 1, 2, 3, 0, 1, 0, 1, 0, 1, 0, 0, 0, 0, 0, 0};
DEV void phase_topk(const Params& p, char* lds) {
  u16* KS = (u16*)lds;
  const u16* keys = (const u16*)(p.ws + OFF_KEYS); const u16* qp = (const u16*)(p.ws + OFF_A);
  int* experts = (int*)(p.ws + OFF_O); float* gates = (float*)(p.ws + OFF_O + (size_t)T * 128 * 4);
  const int tid = TIDX(), lane = tid & 63, w = __builtin_amdgcn_readfirstlane(tid >> 6), r32 = lane & 31, hh = lane >> 5;
  u32x4 kreg[8];
  auto kload = [&](int hc) __attribute__((always_inline)) {
#pragma unroll
    for (int i = 0; i < 8; ++i) { const int id = tid + 256 * i; const int row = id >> 4, ch = id & 15;
      kreg[i] = *(const u32x4*)(keys + ((size_t)hc * 128 + row) * 128 + 8 * ch); }
  };
  if ((int)blockIdx.x < 2048) kload(2 * ((int)blockIdx.x & 7));
#pragma unroll 1
  for (int it = blockIdx.x; it < 2048; it += gridDim.x) {
    const int m0 = real_mtile(it >> 3) * 128; const size_t t = (size_t)m0 + 32 * w + r32;
    const int h = it & 7;
    {
      unsigned LA[16], LB[16];
#pragma unroll
      for (int i = 0; i < 16; ++i) { LA[i] = 0u; LB[i] = 0u; }
#pragma unroll 1
      for (int c = 0; c < 2; ++c) {
        const int hc = 2 * h + c;
        const u16* qrow = qp + t * 2048 + hc * 128 + 8 * hh;
        bf16x8 qf[8];
#pragma unroll
        for (int ks = 0; ks < 8; ++ks) qf[ks] = *(const bf16x8*)(qrow + 16 * ks);
        __syncthreads();
#pragma unroll
        for (int i = 0; i < 8; ++i) { const int id = tid + 256 * i; const int row = id >> 4, ch = id & 15;
          *(u32x4*)(KS + row * 136 + 8 * ch) = kreg[i]; }
        __syncthreads();
        { const int nit = it + (int)gridDim.x; if (c == 0) kload(hc + 1); else if (nit < 2048) kload(2 * (nit & 7)); }
        unsigned Lc[16];
#pragma unroll
        for (int i = 0; i < 16; ++i) Lc[i] = 0u;
#pragma unroll 1
        for (int kt = 0; kt < 4; ++kt) {
          f32x16 acc;
#pragma unroll
          for (int r = 0; r < 16; ++r) acc[r] = 0.f;
#pragma unroll
          for (int ks = 0; ks < 8; ++ks) acc = MFMA(*(const bf16x8*)(KS + (32 * kt + r32) * 136 + 16 * ks + 8 * hh), qf[ks], acc);
          unsigned kb[16];
#pragma unroll
          for (int r = 0; r < 16; ++r) kb[r] = (fkey(acc[r]) & ~127u) | (unsigned)(32 * kt + crow(r, hh));
          sort16_desc(kb);
          merge16_desc(Lc, kb);
        }
        unsigned M[16];
#pragma unroll
        for (int i = 0; i < 16; ++i) M[i] = max(Lc[i], (unsigned)__shfl_xor((int)Lc[15 - i], 32));
        bstage<16, 8>(M); bstage<16, 4>(M); bstage<16, 2>(M); bstage<16, 1>(M);
#pragma unroll
        for (int i = 0; i < 16; ++i) { LA[i] = LB[i]; LB[i] = M[i]; }
      }
      unsigned H2[16], Hb[16];
      {
        float fa[16], fb[16];
#pragma unroll
        for (int i = 0; i < 16; ++i) { fa[i] = kval(LA[i] & ~127u); fb[i] = kval(LB[i] & ~127u); }
#pragma unroll
        for (int j = 0; j < 16; ++j) H2[j] = (fkey(fa[0] + fb[j]) & ~255u) | (unsigned)j;
        sort16_desc(H2);
        static_for<0, 16>([&](auto ix) __attribute__((always_inline)) { constexpr int e = decltype(ix)::value; constexpr int i = C1I[e], j = C1J[e];
          Hb[e] = (fkey(fa[i] + fb[j]) & ~255u) | (unsigned)(i * 16 + j); });
        sort16_desc(Hb); merge16_desc(H2, Hb);
        static_for<0, 16>([&](auto ix) __attribute__((always_inline)) { constexpr int e = decltype(ix)::value; constexpr int i = C2I[e], j = C2J[e];
          Hb[e] = (fkey(fa[i] + fb[j]) & ~255u) | (unsigned)(i * 16 + j); });
        sort16_desc(Hb); merge16_desc(H2, Hb);
        ins16(H2, (fkey(fa[14] + fb[0]) & ~255u) | (unsigned)(14 * 16));
        ins16(H2, (fkey(fa[15] + fb[0]) & ~255u) | (unsigned)(15 * 16));
      }
      unsigned char* tab = (unsigned char*)(lds + 34816) + (w * 32 + r32) * 32;
      if (hh == 0) {
        unsigned pk[8];
#pragma unroll
        for (int i = 0; i < 4; ++i) {
          pk[i] = (LA[4 * i] & 127u) | ((LA[4 * i + 1] & 127u) << 8) | ((LA[4 * i + 2] & 127u) << 16) | ((LA[4 * i + 3] & 127u) << 24);
          pk[4 + i] = (LB[4 * i] & 127u) | ((LB[4 * i + 1] & 127u) << 8) | ((LB[4 * i + 2] & 127u) << 16) | ((LB[4 * i + 3] & 127u) << 24);
        }
        *(u32x4*)tab = u32x4{pk[0], pk[1], pk[2], pk[3]}; *(u32x4*)(tab + 16) = u32x4{pk[4], pk[5], pk[6], pk[7]};
      }
      const float mx = kval(H2[0] & ~255u); float Z = 0.f;
#pragma unroll
      for (int i = 0; i < 16; ++i) Z += __expf(kval(H2[i] & ~255u) - mx);
      const float iz = 1.f / Z;
      int eo[8]; float go[8];
#pragma unroll
      for (int i = 0; i < 8; ++i) {
        const unsigned sel = hh ? 0xffffffffu : 0u;
        const unsigned key = (H2[8 + i] & sel) | (H2[i] & ~sel);
        const unsigned cid = key & 255u;
        eo[i] = (int)tab[cid >> 4] * 128 + (int)tab[16 + (cid & 15u)];
        go[i] = __expf(kval(key & ~255u) - mx) * iz;
      }
      int* ed = experts + t * 128 + h * 16 + 8 * hh; float* gd = gates + t * 128 + h * 16 + 8 * hh;
      *(u32x4*)ed = u32x4{(unsigned)eo[0], (unsigned)eo[1], (unsigned)eo[2], (unsigned)eo[3]}; *(u32x4*)(ed + 4) = u32x4{(unsigned)eo[4], (unsigned)eo[5], (unsigned)eo[6], (unsigned)eo[7]};
      *(f32x4*)gd = f32x4{go[0], go[1], go[2], go[3]}; *(f32x4*)(gd + 4) = f32x4{go[4], go[5], go[6], go[7]};
    }
  }
}

DEV v32f swdec(const v6u& d) {
  v32f o;
  static_for<0, 32>([&](auto ix) __attribute__((always_inline)) {
    constexpr int i = decltype(ix)::value; constexpr int bp = 6 * i, di = bp >> 5, off = bp & 31;
    unsigned f = d[di] >> off;
    if constexpr (off > 26) f |= d[di + 1] << (32 - off);
    f &= 63u;
    const unsigned code = f & 31u; const unsigned e = code >> 3, m = code & 7u;
    float v = (e == 0) ? (float)m * 0.125f : (1.f + (float)m * 0.125f) * (float)(1u << (e - 1));
    o[i] = (f & 32u) ? -v : v;
  });
  return o;
}
DEV v6u ld_row(const unsigned char* p) { const u32x2* q = (const u32x2*)p; const u32x2 a = q[0], b = q[1], c = q[2]; return v6u{a[0], a[1], b[0], b[1], c[0], c[1]}; }
DEV void phase_experts(const Params& p) {
  const u16* h1 = (const u16*)(p.ws + OFF_ST);
  const unsigned char* uq = (const unsigned char*)(p.ws + OFF_TBL + TBL_U); const unsigned char* vq = (const unsigned char*)(p.ws + OFF_TBL + TBL_V);
  const float* tsc = (const float*)(p.ws + OFF_TBL + TBL_SC);
  const int* experts = (const int*)(p.ws + OFF_O); const float* gates = (const float*)(p.ws + OFF_O + (size_t)T * 128 * 4);
  const int tid_ = TIDX(); const int lane = tid_ & 63, w = __builtin_amdgcn_readfirstlane(tid_ >> 6);
  const int c = lane & 31; const bool hi = lane >= 32;
  const int b4 = (lane >> 4) & 1, b3 = (lane >> 3) & 1, b2 = (lane >> 2) & 1, b1 = (lane >> 1) & 1;
  const int kofs = 2 * ((lane >> 1) & 15) + (lane >> 5);
  for (int ti = blockIdx.x * 4 + w; ti < 32768; ti += gridDim.x * 4) {
    const size_t t = (size_t)(ti >> 12) * L + 128 + (ti & 4095);
    unsigned xb[16];
#pragma unroll
    for (int i = 0; i < 4; ++i) { const u32x4 q = *(const u32x4*)(h1 + t * 1024 + 32 * c + 8 * i); xb[4 * i] = q[0]; xb[4 * i + 1] = q[1]; xb[4 * i + 2] = q[2]; xb[4 * i + 3] = q[3]; }
    f32x2 yp[16];
#pragma unroll
    for (int i = 0; i < 16; ++i) yp[i] = f32x2{0.f, 0.f};
    f32x2 xp[16];
#pragma unroll
    for (int i = 0; i < 16; ++i) xp[i] = f32x2{bflo(xb[i]), bfhi(xb[i])};
#pragma unroll 1
    for (int bt = 0; bt < 4; ++bt) {
      const int emine = experts[t * 128 + 32 * bt + kofs]; const float gmine = gates[t * 128 + 32 * bt + kofs];
      const float su = tsc[emine], sv = tsc[16384 + emine];
      float pd[16];
      u32x4 Rv[16];
      {
        u32x4 Ru[16];
#pragma unroll
        for (int j = 0; j < 16; ++j) {
          const int e0 = __builtin_amdgcn_readlane(emine, 2 * j), e1 = __builtin_amdgcn_readlane(emine, 32 + 2 * j);
          Ru[j] = *(const u32x4*)(uq + (size_t)(hi ? e1 : e0) * 512 + 16 * c);
        }
#pragma unroll
        for (int j = 0; j < 16; ++j) {
          const int e0 = __builtin_amdgcn_readlane(emine, 2 * j), e1 = __builtin_amdgcn_readlane(emine, 32 + 2 * j);
          Rv[j] = *(const u32x4*)(vq + (size_t)(hi ? e1 : e0) * 512 + 16 * c);
        }
        __builtin_amdgcn_sched_barrier(0);
#pragma unroll
        for (int j = 0; j < 16; ++j) {
          f32x2 a2 = {0.f, 0.f}, a3 = {0.f, 0.f};
#pragma unroll
          for (int d = 0; d < 4; ++d) {
            a2 = __builtin_elementwise_fma(__builtin_amdgcn_cvt_scalef32_pk_f32_fp4(Ru[j][d], 1.0f, 0), xp[4 * d], a2);
            a3 = __builtin_elementwise_fma(__builtin_amdgcn_cvt_scalef32_pk_f32_fp4(Ru[j][d], 1.0f, 1), xp[4 * d + 1], a3);
            a2 = __builtin_elementwise_fma(__builtin_amdgcn_cvt_scalef32_pk_f32_fp4(Ru[j][d], 1.0f, 2), xp[4 * d + 2], a2);
            a3 = __builtin_elementwise_fma(__builtin_amdgcn_cvt_scalef32_pk_f32_fp4(Ru[j][d], 1.0f, 3), xp[4 * d + 3], a3);
          }
          pd[j] = (a2[0] + a2[1]) + (a3[0] + a3[1]);
        }
      }
#pragma unroll
      for (int i = 0; i < 8; ++i) { const float snd = b4 ? pd[i] : pd[i + 8], kp = b4 ? pd[i + 8] : pd[i]; pd[i] = kp + __shfl_xor(snd, 16); }
#pragma unroll
      for (int i = 0; i < 4; ++i) { const float snd = b3 ? pd[i] : pd[i + 4], kp = b3 ? pd[i + 4] : pd[i]; pd[i] = kp + __shfl_xor(snd, 8); }
#pragma unroll
      for (int i = 0; i < 2; ++i) { const float snd = b2 ? pd[i] : pd[i + 2], kp = b2 ? pd[i + 2] : pd[i]; pd[i] = kp + __shfl_xor(snd, 4); }
      { const float snd = b1 ? pd[0] : pd[1], kp = b1 ? pd[1] : pd[0]; pd[0] = kp + __shfl_xor(snd, 2); }
      const float dv = (pd[0] + __shfl_xor(pd[0], 1)) * su;
      const float act = 0.5f * dv * (1.f + erff(dv * 0.7071067811865476f));
      const float wg = gmine * act * sv;
      {
#pragma unroll
        for (int j = 0; j < 16; ++j) {
          const float w0 = __uint_as_float(__builtin_amdgcn_readlane(__float_as_uint(wg), 2 * j)), w1 = __uint_as_float(__builtin_amdgcn_readlane(__float_as_uint(wg), 32 + 2 * j));
          const float ws = hi ? w1 : w0; const f32x2 ws2 = {ws, ws};
#pragma unroll
          for (int d = 0; d < 4; ++d) {
            yp[4 * d] = __builtin_elementwise_fma(__builtin_amdgcn_cvt_scalef32_pk_f32_fp4(Rv[j][d], 1.0f, 0), ws2, yp[4 * d]);
            yp[4 * d + 1] = __builtin_elementwise_fma(__builtin_amdgcn_cvt_scalef32_pk_f32_fp4(Rv[j][d], 1.0f, 1), ws2, yp[4 * d + 1]);
            yp[4 * d + 2] = __builtin_elementwise_fma(__builtin_amdgcn_cvt_scalef32_pk_f32_fp4(Rv[j][d], 1.0f, 2), ws2, yp[4 * d + 2]);
            yp[4 * d + 3] = __builtin_elementwise_fma(__builtin_amdgcn_cvt_scalef32_pk_f32_fp4(Rv[j][d], 1.0f, 3), ws2, yp[4 * d + 3]);
          }
        }
      }
    }
    float z[16];
#pragma unroll
    for (int i = 0; i < 16; ++i) {
      const float ylo = yp[i >> 1][i & 1], yup = yp[8 + (i >> 1)][i & 1];
      const float lo = ylo + __shfl_xor(ylo, 32), up = yup + __shfl_xor(yup, 32);
      const unsigned xw = hi ? xb[8 + (i >> 1)] : xb[i >> 1];
      const float xv = (i & 1) ? bfhi(xw) : bflo(xw);
      z[i] = DN_ALPHA * xv + (hi ? up : lo);
    }
    float sm = 0.f;
#pragma unroll
    for (int i = 0; i < 16; ++i) sm += z[i];
    const float mu = wsum(sm) * (1.f / 1024.f);
    float q = 0.f;
#pragma unroll
    for (int i = 0; i < 16; ++i) { const float d = z[i] - mu; q += d * d; }
    const float rs = rsqrtf(wsum(q) * (1.f / 1024.f) + LN_EPS);
    const int e0 = 32 * c + (hi ? 16 : 0);
    float* od = p.out + (size_t)ti * 1024 + e0;
    const f32x4* g4 = (const f32x4*)(p.ln2g + e0); const f32x4* bb4 = (const f32x4*)(p.ln2b + e0);
#pragma unroll
    for (int k = 0; k < 4; ++k) {
      const f32x4 g = g4[k], bb = bb4[k]; f32x4 o;
#pragma unroll
      for (int i = 0; i < 4; ++i) o[i] = (z[4 * k + i] - mu) * rs * g[i] + bb[i];
      *(f32x4*)(od + 4 * k) = o;
    }
  }
}

#define XB_TMO      128
#define XB_XCNT(j)  (256  + 64 * (j))
#define XB_XSUB(j)  (1280 + 64 * (j))
#define XB_XGEN(j)  (2304 + 64 * (j))
#define XB_TOP      3328
#define XB_TOPGEN   3392
#define XB_SPIN_CAP (1u << 22)
#define LAS __attribute__((address_space(3)))
DEV unsigned xb_ld(unsigned* p) { return __hip_atomic_load(p, __ATOMIC_RELAXED, __HIP_MEMORY_SCOPE_AGENT); }
DEV unsigned xb_add(unsigned* p, unsigned v) { return __hip_atomic_fetch_add(p, v, __ATOMIC_RELAXED, __HIP_MEMORY_SCOPE_AGENT); }
DEV unsigned xb_xcc_id() { return (unsigned)__builtin_amdgcn_s_getreg((3 << 11) | 20) & 0xFu; }
#define XB_SPIN(cond, bar) do { unsigned _sp = 0; while (cond) { __builtin_amdgcn_s_sleep(1); \
    if ((++_sp & 255u) == 0u) { if (xb_ld(&(bar)[XB_TMO])) break; if (_sp > XB_SPIN_CAP) { atomicAdd(&(bar)[XB_TMO], 1u); break; } } } } while (0)
struct XcdBarrier { unsigned* bar; unsigned x; volatile LAS unsigned* st; };
DEV XcdBarrier xcd_barrier_post(unsigned* bar, volatile LAS unsigned* st) {
  XcdBarrier b; b.bar = bar; b.x = xb_xcc_id(); b.st = st;
  if (threadIdx.x == 0) (void)xb_add(&bar[XB_XCNT(b.x)], 1u);
  return b;
}
DEV void xcd_barrier_complete(unsigned* bar, unsigned x, unsigned& nloc, unsigned& nx) {
  const unsigned G = gridDim.x;
  unsigned sum, cnt, mine, sp = 0u;
  for (;;) {
    sum = 0u; cnt = 0u; mine = 0u;
#pragma unroll
    for (unsigned j = 0; j < 16; ++j) { const unsigned c = xb_ld(&bar[XB_XCNT(j)]); sum += c; cnt += (c > 0u) ? 1u : 0u; mine = (j == x) ? c : mine; }
    if (sum == G) break;
    __builtin_amdgcn_s_sleep(1);
    if ((++sp & 255u) == 0u) { if (xb_ld(&bar[XB_TMO])) break; if (sp > XB_SPIN_CAP) { atomicAdd(&bar[XB_TMO], 1u); break; } }
  }
  nloc = mine > 0u ? mine : 1u; nx = cnt > 0u ? cnt : 1u;
}
DEV void xcd_barrier(const XcdBarrier& b) {
  asm volatile("s_waitcnt vmcnt(0)" ::: "memory");
  __syncthreads();
  if (threadIdx.x == 0) {
    unsigned* bar = b.bar;
    __builtin_amdgcn_s_waitcnt(0);
    unsigned nloc = b.st[0], nx = b.st[1];
    if (nloc == 0u) { xcd_barrier_complete(bar, b.x, nloc, nx); b.st[0] = nloc; b.st[1] = nx; }
    const unsigned old = xb_add(&bar[XB_XSUB(b.x)], 1u);
    const unsigned gen = old / nloc;
    if (old + 1u == (gen + 1u) * nloc) {
      __builtin_amdgcn_fence(__ATOMIC_RELEASE, "agent");
      asm volatile("s_waitcnt vmcnt(0)" ::: "memory");
      const unsigned og = xb_add(&bar[XB_TOP], 1u);
      const unsigned tg = og / nx;
      if (og + 1u == (tg + 1u) * nx) xb_add(&bar[XB_TOPGEN], 1u);
      else XB_SPIN(xb_ld(&bar[XB_TOPGEN]) == tg, bar);
      __builtin_amdgcn_fence(__ATOMIC_ACQUIRE, "agent");
      xb_add(&bar[XB_XGEN(b.x)], 1u);
      asm volatile("s_waitcnt vmcnt(0)" ::: "memory");
    } else {
      XB_SPIN(xb_ld(&bar[XB_XGEN(b.x)]) == gen, bar);
      __builtin_amdgcn_fence(__ATOMIC_ACQUIRE, "agent");
      asm volatile("s_waitcnt vmcnt(0)" ::: "memory");
    }
  }
  __syncthreads();
}
DEV void grid_barrier(unsigned* ctr, unsigned target) {
  asm volatile("s_waitcnt vmcnt(0)" ::: "memory");
  __syncthreads();
  if (TIDX() == 0) {
    __builtin_amdgcn_fence(__ATOMIC_RELEASE, "agent");
    asm volatile("s_waitcnt vmcnt(0)" ::: "memory");
    __hip_atomic_fetch_add(ctr, 1u, __ATOMIC_RELAXED, __HIP_MEMORY_SCOPE_AGENT);
    while (__hip_atomic_load(ctr, __ATOMIC_RELAXED, __HIP_MEMORY_SCOPE_AGENT) < target) __builtin_amdgcn_s_sleep(2);
    __builtin_amdgcn_fence(__ATOMIC_ACQUIRE, "agent");
    asm volatile("s_waitcnt vmcnt(0)" ::: "memory");
  }
  __syncthreads();
}
constexpr int NPHASE = 10;
constexpr int LDS_BYTES = 55296 + 64;
template <int PH> DEV void run_phase(const Params& p0, char* lds) {
  Params p = p0;
  { size_t z = 0; asm volatile("" : "+s"(z) :: "memory"); p.ws = p0.ws + z; p.out = p0.out + z; }
  if constexpr (PH == 0) phase_prep(p, lds);
  if constexpr (PH == 1) phase_proj(p, lds);
  if constexpr (PH == 2) phase_g1(p, lds);
  if constexpr (PH == 3) phase_scan(p);
  if constexpr (PH == 4) phase_mix(p, lds);
  if constexpr (PH == 5) phase_outproj(p, lds);
  if constexpr (PH == 6) phase_ln1(p);
  if constexpr (PH == 7) phase_peerq(p, lds);
  if constexpr (PH == 8) phase_topk(p, lds);
  if constexpr (PH == 9) phase_experts(p);
}
#if MODE == 0
template <int PH> __global__ void __launch_bounds__(256, 2) phase_kernel(Params p) {
  __shared__ __attribute__((aligned(16))) char lds[LDS_BYTES];
  run_phase<PH>(p, lds);
}
#else
__global__ void __launch_bounds__(256, 2) mega(Params p) {
  __shared__ __attribute__((aligned(16))) char lds[LDS_BYTES];
  cg::grid_group grid = cg::this_grid();
#ifndef PHMASK
#define PHMASK 0x3ff
#endif
#ifndef DUP
#define DUP -1
#endif
#define RUNPH(i) if constexpr ((PHMASK >> i) & 1) { run_phase<i>(p, lds); if constexpr (i == DUP) { __syncthreads(); run_phase<i>(p, lds); } }
  __shared__ uint4 xb_words;
  if (threadIdx.x == 0) xb_words = make_uint4(0u, 0u, 0u, 0u);
  __syncthreads();
  XcdBarrier xb = xcd_barrier_post((unsigned*)(p.ws + OFF_BAR + 4096), (volatile LAS unsigned*)&xb_words);
  if (p.ws == nullptr) grid.sync();
  RUNPH(0); xcd_barrier(xb);
  RUNPH(1); xcd_barrier(xb);
  RUNPH(2); xcd_barrier(xb);
  RUNPH(3); xcd_barrier(xb);
  RUNPH(4); xcd_barrier(xb);
  RUNPH(5); xcd_barrier(xb);
  RUNPH(6); xcd_barrier(xb);
  RUNPH(7); xcd_barrier(xb);
  RUNPH(8); xcd_barrier(xb);
  RUNPH(9);
}
#endif

extern "C" void kernel_launch(void* const* d_in, const int* in_sizes, int n_in, void* d_out, int out_size, void* d_ws, size_t ws_size,
                              hipStream_t stream) {
  Params p{};
  p.x = (const float*)d_in[0]; p.meta = (const float*)d_in[1]; p.eg = (const float*)d_in[2]; p.eb = (const float*)d_in[3];
  p.w_in = (const float*)d_in[4]; p.w_gu = (const float*)d_in[5]; p.b_gate = (const float*)d_in[6]; p.b_forget = (const float*)d_in[7];
  p.gng = (const float*)d_in[8]; p.fng = (const float*)d_in[9]; p.w_out = (const float*)d_in[10]; p.ln1g = (const float*)d_in[11];
  p.ln1b = (const float*)d_in[12]; p.wq = (const float*)d_in[13]; p.subk = (const float*)d_in[14]; p.pu = (const float*)d_in[15];
  p.pv = (const float*)d_in[16]; p.ln2g = (const float*)d_in[17]; p.ln2b = (const float*)d_in[18];
  p.out = (float*)d_out; p.ws = (char*)d_ws;
  if (ws_size < WS_END) { fprintf(stderr, "workspace too small\n"); return; }
#if MODE == 0
  phase_kernel<0><<<dim3(1024), dim3(256), 0, stream>>>(p);
  phase_kernel<1><<<dim3(1024), dim3(256), 0, stream>>>(p);
  phase_kernel<2><<<dim3(1024), dim3(256), 0, stream>>>(p);
  phase_kernel<3><<<dim3(1024), dim3(256), 0, stream>>>(p);
  phase_kernel<4><<<dim3(1024), dim3(256), 0, stream>>>(p);
  phase_kernel<5><<<dim3(1024), dim3(256), 0, stream>>>(p);
  phase_kernel<6><<<dim3(1024), dim3(256), 0, stream>>>(p);
  phase_kernel<7><<<dim3(1024), dim3(256), 0, stream>>>(p);
  phase_kernel<8><<<dim3(256), dim3(256), 0, stream>>>(p);
  phase_kernel<9><<<dim3(2048), dim3(256), 0, stream>>>(p);
#else
  static int grid_blocks = 0;
  if (!grid_blocks) {
    int dev = 0, cus = 0, per_cu = 0;
    hipGetDevice(&dev);
    hipDeviceGetAttribute(&cus, hipDeviceAttributeMultiprocessorCount, dev);
    hipOccupancyMaxActiveBlocksPerMultiprocessor(&per_cu, mega, 256, 0);
    if (per_cu > 2) per_cu = 2;
    grid_blocks = cus * per_cu;
  }
  hipMemsetAsync((char*)d_ws + OFF_BAR, 0, 4096 + 16384, stream);
  void* args[] = {&p};
  hipError_t e = hipLaunchCooperativeKernel((void*)mega, dim3(grid_blocks), dim3(256), args, 0, stream);
  if (e != hipSuccess) fprintf(stderr, "cooperative launch failed: %s (grid %d)\n", hipGetErrorString(e), grid_blocks);
#endif
}
```
